# Optimizing an MI355X kernel written in HIP

```python
import jax, jax.numpy as jnp
from jax import lax
import numpy as np

D_MODEL = 1024
BATCH = 8
SEQ = 4096
DEPTH = 1

CHUNK = 64
CONV_WIDTH = D_MODEL // 2
CONV_KERNEL = 31
HG_WIDTH = D_MODEL // 2
HG_HEAD_DIM = 128
HG_HEADS = HG_WIDTH // HG_HEAD_DIM
D_FF = 4 * D_MODEL
N_BRANCHES = 2
NORM_EPS = 1e-6
LN_EPS = 1e-5
IN_COLS = 2 * CONV_WIDTH + 4 * HG_WIDTH + N_BRANCHES * D_MODEL

kernel_name = "conv_hgrn2_gated_hybrid_block"


def rms_norm(x, w):
    xf = x.astype(jnp.float32)
    y = xf * lax.rsqrt(jnp.mean(xf * xf, axis=-1, keepdims=True) + NORM_EPS)
    return (y * w.astype(jnp.float32)).astype(x.dtype)


def layer_norm(x, w, b):
    xf = x.astype(jnp.float32)
    mu = jnp.mean(xf, axis=-1, keepdims=True)
    xc = xf - mu
    var = jnp.mean(xc * xc, axis=-1, keepdims=True)
    y = xc * lax.rsqrt(var + LN_EPS) * w.astype(jnp.float32) + b.astype(jnp.float32)
    return y.astype(x.dtype)


def split_points():
    sizes = [CONV_WIDTH, CONV_WIDTH, HG_WIDTH, HG_WIDTH, HG_WIDTH, HG_WIDTH, D_MODEL]
    pts, acc = [], 0
    for s in sizes:
        acc += s
        pts.append(acc)
    return pts


def conformer_conv(a, a_gate, dw_w, dw_b, ln_w, ln_b, w_pw, b_pw):
    u = a * jax.nn.sigmoid(a_gate)
    u = lax.conv_general_dilated(
        u, dw_w.astype(u.dtype), window_strides=(1,),
        padding=[(CONV_KERNEL - 1, 0)],
        dimension_numbers=("NWC", "WIO", "NWC"),
        feature_group_count=CONV_WIDTH) + dw_b
    u = jax.nn.silu(layer_norm(u, ln_w, ln_b))
    return u @ w_pw + b_pw


def hgrn2_step(state, inp):
    q, k, v, g = inp
    b = jnp.cumsum(g, axis=2)
    o_inter = jnp.einsum("bhtk,bhkv->bhtv", q * jnp.exp(b), state)
    causal = jnp.tril(jnp.ones((CHUNK, CHUNK), dtype=bool))
    diff = b[:, :, :, None, :] - b[:, :, None, :, :]
    decay = jnp.exp(jnp.where(causal[None, None, :, :, None], diff, -jnp.inf))
    scores = jnp.einsum("bhtk,bhsk,bhtsk->bhts", q, k, decay)
    o = o_inter + jnp.einsum("bhts,bhsv->bhtv", scores, v)
    b_last = b[:, :, -1:, :]
    new_state = jnp.exp(b_last[:, :, 0, :])[..., None] * state + jnp.einsum(
        "bhsk,bhsv->bhkv", k * jnp.exp(b_last - b), v)
    return new_state, o


def hgrn2(q, f_logit, i, g_out, lb, norm_w, w_o):
    B, S, _ = q.shape
    n_chunks = S // CHUNK
    f = lb + (1.0 - lb) * jax.nn.sigmoid(f_logit.astype(jnp.float32))
    log_f = jnp.log(f)
    k = 1.0 - f

    def to_chunks(t):
        return t.astype(jnp.float32).reshape(B, n_chunks, CHUNK, HG_HEADS, HG_HEAD_DIM).transpose(1, 0, 3, 2, 4)

    qs, ks, vs, gs = to_chunks(q), to_chunks(k), to_chunks(i), to_chunks(log_f)
    s0 = jnp.zeros((B, HG_HEADS, HG_HEAD_DIM, HG_HEAD_DIM), jnp.float32)
    _, o = lax.scan(hgrn2_step, s0, (qs, ks, vs, gs))
    o = o.transpose(1, 0, 3, 2, 4).reshape(B, S, HG_HEADS, HG_HEAD_DIM)
    o = o * lax.rsqrt(jnp.mean(o * o, axis=-1, keepdims=True) + NORM_EPS)
    o = o * norm_w.astype(jnp.float32).reshape(HG_HEADS, HG_HEAD_DIM)
    o = o.reshape(B, S, HG_WIDTH) * jax.nn.silu(g_out.astype(jnp.float32))
    return o.astype(q.dtype) @ w_o


def setup_inputs(seed: int = 0) -> dict:
    key = jax.random.key(seed)
    ks = jax.random.split(key, 17)

    def nrm(k, shape, scale):
        return jax.random.normal(k, shape, jnp.float32) * scale

    return {
        "x": nrm(ks[0], (BATCH, SEQ, D_MODEL), 1.0),
        "norm_mix_w": 1.0 + nrm(ks[1], (DEPTH, D_MODEL), 0.02),
        "w_in": nrm(ks[2], (DEPTH, D_MODEL, IN_COLS), D_MODEL ** -0.5),
        "dw_conv_w": nrm(ks[3], (DEPTH, CONV_KERNEL, 1, CONV_WIDTH), CONV_KERNEL ** -0.5),
        "dw_conv_b": nrm(ks[4], (DEPTH, CONV_WIDTH), 0.02),
        "conv_ln_w": 1.0 + nrm(ks[5], (DEPTH, CONV_WIDTH), 0.02),
        "conv_ln_b": nrm(ks[6], (DEPTH, CONV_WIDTH), 0.02),
        "w_conv_out": nrm(ks[7], (DEPTH, CONV_WIDTH, D_MODEL), CONV_WIDTH ** -0.5),
        "b_conv_out": nrm(ks[8], (DEPTH, D_MODEL), 0.02),
        "hgrn_lb": nrm(ks[9], (DEPTH + 1, HG_WIDTH), 0.1),
        "hgrn_norm_w": 1.0 + nrm(ks[10], (DEPTH, HG_WIDTH), 0.02),
        "w_hgrn_out": nrm(ks[11], (DEPTH, HG_WIDTH, D_MODEL), HG_WIDTH ** -0.5),
        "w_out": nrm(ks[12], (DEPTH, D_MODEL, D_MODEL), D_MODEL ** -0.5),
        "norm_mlp_w": 1.0 + nrm(ks[13], (DEPTH, D_MODEL), 0.02),
        "w_mlp_up": nrm(ks[14], (DEPTH, D_MODEL, D_FF), D_MODEL ** -0.5),
        "w_mlp_down": nrm(ks[15], (DEPTH, D_FF, D_MODEL), D_FF ** -0.5),
        "norm_final_w": 1.0 + nrm(ks[16], (D_MODEL,), 0.02),
    }


def reference(x, norm_mix_w, w_in, dw_conv_w, dw_conv_b, conv_ln_w, conv_ln_b,
              w_conv_out, b_conv_out, hgrn_lb, hgrn_norm_w, w_hgrn_out, w_out,
              norm_mlp_w, w_mlp_up, w_mlp_down, norm_final_w):
    lower_bounds = jnp.cumsum(jax.nn.softmax(hgrn_lb.astype(jnp.float32), axis=0), axis=0)
    pts = split_points()
    for l in range(DEPTH):
        h = rms_norm(x, norm_mix_w[l])
        proj = h @ w_in[l]
        a, a_gate, hq, hf, hi, hg, gate_a, gate_b = jnp.split(proj, pts, axis=-1)
        y_conv = conformer_conv(a, a_gate, dw_conv_w[l], dw_conv_b[l], conv_ln_w[l], conv_ln_b[l],
                                w_conv_out[l], b_conv_out[l])
        y_rec = hgrn2(hq, hf, hi, hg, lower_bounds[l], hgrn_norm_w[l], w_hgrn_out[l])
        y = jax.nn.sigmoid(gate_a) * y_conv + jax.nn.sigmoid(gate_b) * y_rec
        x = x + y @ w_out[l]
        h = rms_norm(x, norm_mlp_w[l])
        x = x + jnp.square(jax.nn.relu(h @ w_mlp_up[l])) @ w_mlp_down[l]
    return rms_norm(x, norm_final_w)
```

```cpp
#include <hip/hip_runtime.h>
#include <hip/hip_cooperative_groups.h>
#include <cstdio>
#include <cstdint>
namespace cg = cooperative_groups;

#ifndef MK_N_LAUNCHES
#define MK_N_LAUNCHES 1
#endif

#define LAS __attribute__((address_space(3)))
typedef unsigned short bf16_t;
typedef short bf16x8 __attribute__((ext_vector_type(8)));
typedef float f32x4 __attribute__((ext_vector_type(4)));
typedef float f32x2 __attribute__((ext_vector_type(2)));
typedef unsigned u32x4 __attribute__((ext_vector_type(4)));
typedef unsigned u32x2 __attribute__((ext_vector_type(2)));
typedef __bf16 bf16x2v __attribute__((ext_vector_type(2)));

__device__ __forceinline__ unsigned pk_bf16(float lo, float hi) { f32x2 v = {lo, hi}; bf16x2v b = __builtin_convertvector(v, bf16x2v); return __builtin_bit_cast(unsigned, b); }
__device__ __forceinline__ float bf_lo(unsigned w) { return __uint_as_float(w << 16); }
__device__ __forceinline__ float bf_hi(unsigned w) { return __uint_as_float(w & 0xffff0000u); }
__device__ __forceinline__ float sigm(float x) { return __builtin_amdgcn_rcpf(1.0f + __expf(-x)); }
__device__ __forceinline__ float wave_sum(float v) {
#pragma unroll
    for (int o = 1; o < 64; o <<= 1) v += __shfl_xor(v, o);
    return v;
}

namespace pg8 {
#define PG8_LAS __attribute__((address_space(3)))
constexpr int BM = 256, BK = 64, HALF = 128, HTB = HALF * BK * 2, STAGE_BYTES = 8 * HTB, NXCD = 8, WGM = 8;
__host__ __device__ __forceinline__ int lds_byte(int r, int c) { const int st = (r >> 4) * 2 + (c >> 5), rr = r & 15, cc = c & 31, ob = rr * 64 + cc * 2; return st * 1024 + (ob ^ (((ob >> 9) & 1) << 5)); }
__host__ __device__ __forceinline__ void stage_rc(int b, int& R, int& C) { const int st = b / 1024, sb = b % 1024, swz = sb ^ (((sb >> 9) & 1) << 5); R = (st >> 1) * 16 + swz / 64; C = (st & 1) * 32 + (swz % 64) / 2; }
__host__ __device__ __forceinline__ int perm32(int rho) { const int n = rho >> 4, i = rho & 15; return 8 * (i >> 2) + 4 * n + (i & 3); }

struct Unit { int pm, pn; };
struct Gemm { const bf16_t* A; const bf16_t* Bt; int M, N, K; };

struct StaticOrder {
    int nM, nN, nwg, G, c;
    __host__ __device__ void init(int M, int N, int G_, int c_) { nM = M / BM; nN = N / BM; nwg = nM * nN; G = G_; c = c_; }
    __host__ __device__ bool next(int i, Unit& u) const {
        const long L = (long)i * G + c; if (L >= nwg) return false;
        int wgid = (int)L; { const int q = nwg / NXCD, r = nwg % NXCD, xcd = wgid % NXCD, off = wgid / NXCD; wgid = (xcd < r ? xcd * (q + 1) : r * (q + 1) + (xcd - r) * q) + off; }
        const int nig = WGM * nN, gid = wgid / nig, fm = gid * WGM, gsz = (nM - fm) < WGM ? (nM - fm) : WGM;
        u.pm = fm + ((wgid % nig) % gsz); u.pn = (wgid % nig) / gsz; return true;
    }
};

template <class Epi, bool ALIGN_EPI = true>
__device__ __forceinline__ void gemm_phase(PG8_LAS unsigned char* lds, const Gemm g, const StaticOrder& S, const Epi& E) {
    const int tid = threadIdx.x, wid = __builtin_amdgcn_readfirstlane(tid >> 6), lane = tid & 63, wr = wid >> 2, wc = wid & 3, fr = lane & 15, fq = lane >> 4;
    const int K = g.K, nt = K / BK;
    unsigned voffA[2], voffB[2];
#pragma unroll
    for (int i = 0; i < 2; ++i) { int R, C; stage_rc(tid * 16 + i * 8192, R, C); const int Rb = Epi::PERM ? ((R & ~31) + perm32(R & 31)) : R;
        voffA[i] = (unsigned)(R * K + C) * 2u; voffB[i] = (unsigned)(Rb * K + C) * 2u; }
    const size_t kstep = (size_t)(BK * 2);
    const size_t hstep = (size_t)HALF * K * 2;
    const size_t tstep = 2 * hstep;
    const unsigned ldsw = (unsigned)wid * 1024u;
    const int aoff = lds_byte(wr * 64 + fr, fq * 8), boff = lds_byte(wc * 32 + fr, fq * 8);
#define PG8_SA(b, h) (((b) * 2 + (h)) * HTB)
#define PG8_SB(b, h) ((4 + (b) * 2 + (h)) * HTB)
#define PG8_STAGE(bufoff, gbase, voff) do { _Pragma("unroll") for (int _i = 0; _i < 2; ++_i) \
        __builtin_amdgcn_global_load_lds((const unsigned*)((const char*)(gbase) + (voff)[_i]), (PG8_LAS unsigned*)(lds + (bufoff) + ldsw + _i * 8192), 16, 0, 0); } while (0)
#define PG8_LDA(dst, b, h) do { _Pragma("unroll") for (int m = 0; m < 4; ++m) _Pragma("unroll") for (int k = 0; k < 2; ++k) dst[m][k] = *(const PG8_LAS bf16x8*)(lds + PG8_SA(b, h) + aoff + m * 2048 + k * 1024); } while (0)
#define PG8_LDB(dst, b, h) do { _Pragma("unroll") for (int n = 0; n < 2; ++n) _Pragma("unroll") for (int k = 0; k < 2; ++k) dst[n][k] = *(const PG8_LAS bf16x8*)(lds + PG8_SB(b, h) + boff + n * 2048 + k * 1024); } while (0)
#define PG8_MMA(ai, bj, At, Bt) do { __builtin_amdgcn_s_setprio(1); _Pragma("unroll") for (int m = 0; m < 4; ++m) _Pragma("unroll") for (int n = 0; n < 2; ++n) _Pragma("unroll") for (int k = 0; k < 2; ++k) \
        acc[ai][bj][m][n] = __builtin_amdgcn_mfma_f32_16x16x32_bf16(Bt[n][k], At[m][k], acc[ai][bj][m][n], 0, 0, 0); __builtin_amdgcn_s_setprio(0); } while (0)
#define PG8_WAIT_V(n) asm volatile("s_waitcnt vmcnt(" #n ")" ::: "memory")
#define PG8_WAIT_L(n) asm volatile("s_waitcnt lgkmcnt(" #n ")" ::: "memory")
#define PG8_BAR __builtin_amdgcn_s_barrier()
#define PG8_SCHED __builtin_amdgcn_sched_barrier(0)
    Unit cur, nxt; int ui = 0;
    if (!S.next(0, cur)) return;
    f32x4 acc[2][2][4][2];
#pragma unroll
    for (int a = 0; a < 2; ++a)
#pragma unroll
        for (int b = 0; b < 2; ++b)
#pragma unroll
            for (int m = 0; m < 4; ++m)
#pragma unroll
                for (int n = 0; n < 2; ++n) acc[a][b][m][n] = (f32x4){0.f, 0.f, 0.f, 0.f};
    bf16x8 At[4][2], B0[2][2], B1[2][2];
    const char* cA = (const char*)g.A + (size_t)cur.pm * tstep; const char* cB = (const char*)g.Bt + (size_t)cur.pn * tstep;
    PG8_STAGE(PG8_SB(0, 0), cB, voffB); PG8_STAGE(PG8_SB(0, 1), cB + hstep, voffB); PG8_STAGE(PG8_SA(0, 0), cA, voffA); PG8_STAGE(PG8_SA(0, 1), cA + hstep, voffA);
    if (wr == 1) PG8_BAR;
    PG8_WAIT_V(2); PG8_BAR;
    PG8_STAGE(PG8_SB(1, 0), cB + kstep, voffB); PG8_STAGE(PG8_SA(1, 0), cA + kstep, voffA); PG8_STAGE(PG8_SB(1, 1), cB + hstep + kstep, voffB);
    PG8_WAIT_V(6); PG8_BAR;
    for (;;) {
        const bool has_next = S.next(ui + 1, nxt);
        const char* nA = has_next ? (const char*)g.A + (size_t)nxt.pm * tstep : cA; const char* nB = has_next ? (const char*)g.Bt + (size_t)nxt.pn * tstep : cB;
        for (int t = 0; t < nt; t += 2) {
            const bool last = (t == nt - 2);
            const char* a1 = cA + (size_t)(t + 1) * kstep;
            const char* a2 = last ? nA : cA + (size_t)(t + 2) * kstep; const char* b2 = last ? nB : cB + (size_t)(t + 2) * kstep;
            const char* a3 = a2 + kstep; const char* b3 = b2 + kstep;
            PG8_LDB(B0, 0, 0); PG8_LDB(B1, 0, 1); PG8_SCHED; PG8_LDA(At, 0, 0); PG8_STAGE(PG8_SA(1, 1), a1 + hstep, voffA);
            PG8_WAIT_V(8); PG8_WAIT_L(0); PG8_BAR; PG8_MMA(0, 0, At, B0); PG8_MMA(0, 1, At, B1); PG8_BAR; PG8_SCHED;
            PG8_LDA(At, 0, 1); PG8_STAGE(PG8_SB(0, 0), b2, voffB); PG8_STAGE(PG8_SB(0, 1), b2 + hstep, voffB); PG8_STAGE(PG8_SA(0, 0), a2, voffA);
            PG8_WAIT_V(8); PG8_WAIT_L(0); PG8_BAR; PG8_MMA(1, 0, At, B0); PG8_MMA(1, 1, At, B1); PG8_BAR; PG8_SCHED;
            PG8_LDB(B0, 1, 0); PG8_LDB(B1, 1, 1); PG8_SCHED; PG8_LDA(At, 1, 0); PG8_STAGE(PG8_SA(0, 1), a2 + hstep, voffA);
            PG8_WAIT_V(8); PG8_WAIT_L(0); PG8_BAR; PG8_MMA(0, 0, At, B0); PG8_MMA(0, 1, At, B1); PG8_BAR; PG8_SCHED;
            PG8_LDA(At, 1, 1); PG8_STAGE(PG8_SB(1, 0), b3, voffB); PG8_STAGE(PG8_SB(1, 1), b3 + hstep, voffB); PG8_STAGE(PG8_SA(1, 0), a3, voffA);
            PG8_WAIT_V(8); PG8_WAIT_L(0); PG8_BAR; PG8_MMA(1, 0, At, B0); PG8_MMA(1, 1, At, B1); PG8_BAR; PG8_SCHED;
            if constexpr (Epi::MID > 0) { if (t + 2 == Epi::MID) { int fr_ = fr, fq_ = fq; asm volatile("" : "+v"(fr_), "+v"(fq_)); E.mid(acc, cur, wr, wc, fr_, fq_); } }
        }
        if constexpr (ALIGN_EPI) { if (wr == 0) PG8_BAR; }
        { int fr_ = fr, fq_ = fq; asm volatile("" : "+v"(fr_), "+v"(fq_)); E(acc, cur, wr, wc, fr_, fq_); }
        if (!has_next) break;
#pragma unroll
        for (int a = 0; a < 2; ++a)
#pragma unroll
            for (int b = 0; b < 2; ++b)
#pragma unroll
                for (int m = 0; m < 4; ++m)
#pragma unroll
                    for (int n = 0; n < 2; ++n) acc[a][b][m][n] = (f32x4){0.f, 0.f, 0.f, 0.f};
        cur = nxt; cA = nA; cB = nB; ++ui;
        if constexpr (ALIGN_EPI) { if (wr == 1) PG8_BAR; }
    }
    PG8_WAIT_V(0);
    if constexpr (!ALIGN_EPI) { if (wr == 0) PG8_BAR; }
    PG8_BAR;
#undef PG8_SA
#undef PG8_SB
#undef PG8_STAGE
#undef PG8_LDA
#undef PG8_LDB
#undef PG8_MMA
#undef PG8_WAIT_V
#undef PG8_WAIT_L
#undef PG8_BAR
#undef PG8_SCHED
}
}

constexpr int NWAVES = 8, NTHR = 512;
constexpr int BATCH = 8, SEQ = 4096, D = 1024, M = BATCH * SEQ;
constexpr int CW = 512, HW = 512, HD = 128, NH = 4, FF = 4096, CK = 31, CH = 64, NCH = SEQ / CH;
constexpr int INC = 5120;
constexpr int NUNIT = BATCH * NCH * NH;
constexpr float NORM_EPS = 1e-6f, LN_EPS = 1e-5f;
constexpr float SS_SCALE = 16777216.0f, SS_INV = 1.0f / (16777216.0f * 1024.0f);

constexpr size_t MiB = 1u << 20;
constexpr size_t WS_RSTD1 = 1 * MiB;
constexpr size_t WS_SS2 = 1 * MiB + 256 * 1024;
constexpr size_t WS_SS3 = 1 * MiB + 512 * 1024;
constexpr size_t WS_DCH = 2 * MiB;
constexpr size_t WS_WIN = 4 * MiB;
constexpr size_t WS_WCAT = 14 * MiB;
constexpr size_t WS_WOUT = 16 * MiB;
constexpr size_t WS_WUP = 18 * MiB;
constexpr size_t WS_WDN = 26 * MiB;
constexpr size_t WS_XB = 34 * MiB;
constexpr size_t WS_SCH = WS_XB, WS_X1B = WS_XB;
constexpr size_t WS_U = 98 * MiB;
constexpr size_t WS_Q = 130 * MiB, WS_G = 162 * MiB, WS_V = 194 * MiB, WS_SG = 226 * MiB;
constexpr size_t WS_RAT = 258 * MiB, WS_GB = 322 * MiB;
constexpr size_t WS_YA = 386 * MiB;
constexpr size_t WS_Y = 98 * MiB;
constexpr size_t WS_HID = 98 * MiB;
constexpr size_t WS_END = 450 * MiB;
static_assert(WS_HID + (size_t)M * FF * 2 <= WS_YA + (size_t)M * D * 2 && WS_YA + (size_t)M * D * 2 == WS_END, "ws map");

constexpr int LDS_BYTES = 147456;

using pg8::Unit; using pg8::BM; using pg8::HALF;

struct EpiProj {
    static constexpr bool PERM = true; static constexpr int MID = 0;
    const float* rstd; const float* lbp; bf16_t *U, *Q, *G, *V, *SG, *RAT, *GB;
    __device__ __forceinline__ void operator()(const f32x4 (&acc)[2][2][4][2], const Unit& u, int wr, int wc, int fr, int fq) const {
        const int row0 = u.pm * BM + wr * 64 + fr, cw = wc * 32 + 8 * fq, pn = u.pn;
        if (pn < 4) {
#pragma unroll
            for (int ai = 0; ai < 2; ++ai)
#pragma unroll
                for (int m = 0; m < 4; ++m) { const int row = row0 + ai * HALF + m * 16; const float rs = rstd[row];
                    const f32x4 a0 = acc[ai][0][m][0] * rs, g0 = acc[ai][1][m][0] * rs, a1 = acc[ai][0][m][1] * rs, g1 = acc[ai][1][m][1] * rs;
                    u32x4 w; w.x = pk_bf16(a0[0] * sigm(g0[0]), a0[1] * sigm(g0[1])); w.y = pk_bf16(a0[2] * sigm(g0[2]), a0[3] * sigm(g0[3]));
                    w.z = pk_bf16(a1[0] * sigm(g1[0]), a1[1] * sigm(g1[1])); w.w = pk_bf16(a1[2] * sigm(g1[2]), a1[3] * sigm(g1[3]));
                    *(u32x4*)(U + (size_t)row * CW + pn * 128 + cw) = w; }
        } else if (pn < 12) {
            const int mode = (pn - 4) >> 1, cb = ((pn - 4) & 1) * 256;
            bf16_t* dst = Q + (size_t)mode * ((size_t)M * HW);
            if (mode == 1) {
#pragma unroll
                for (int bj = 0; bj < 2; ++bj) { const int c = cb + bj * HALF + cw;
                    const f32x4 l0a = *(const f32x4*)(lbp + c), l0b = *(const f32x4*)(lbp + c + 4), l1a = *(const f32x4*)(lbp + HW + c), l1b = *(const f32x4*)(lbp + HW + c + 4);
                    f32x4 lba, lbb;
#pragma unroll
                    for (int j = 0; j < 4; ++j) { lba[j] = sigm(l0a[j] - l1a[j]); lbb[j] = sigm(l0b[j] - l1b[j]); }
#pragma unroll
                    for (int ai = 0; ai < 2; ++ai)
#pragma unroll
                        for (int m = 0; m < 4; ++m) { const int row = row0 + ai * HALF + m * 16; const float rs = rstd[row];
                            f32x4 z0 = acc[ai][bj][m][0] * rs, z1 = acc[ai][bj][m][1] * rs;
#pragma unroll
                            for (int j = 0; j < 4; ++j) { z0[j] = __logf(lba[j] + (1.0f - lba[j]) * sigm(z0[j])); z1[j] = __logf(lbb[j] + (1.0f - lbb[j]) * sigm(z1[j])); }
                            u32x4 w; w.x = pk_bf16(z0[0], z0[1]); w.y = pk_bf16(z0[2], z0[3]); w.z = pk_bf16(z1[0], z1[1]); w.w = pk_bf16(z1[2], z1[3]);
                            *(u32x4*)(dst + (size_t)row * HW + c) = w; } }
            } else {
#pragma unroll
                for (int ai = 0; ai < 2; ++ai)
#pragma unroll
                    for (int m = 0; m < 4; ++m) { const int row = row0 + ai * HALF + m * 16; const float rs = rstd[row];
#pragma unroll
                        for (int bj = 0; bj < 2; ++bj) { f32x4 z0 = acc[ai][bj][m][0] * rs, z1 = acc[ai][bj][m][1] * rs;
                            if (mode == 3) {
#pragma unroll
                                for (int j = 0; j < 4; ++j) { z0[j] = z0[j] * sigm(z0[j]); z1[j] = z1[j] * sigm(z1[j]); } }
                            u32x4 w; w.x = pk_bf16(z0[0], z0[1]); w.y = pk_bf16(z0[2], z0[3]); w.z = pk_bf16(z1[0], z1[1]); w.w = pk_bf16(z1[2], z1[3]);
                            *(u32x4*)(dst + (size_t)row * HW + cb + bj * HALF + cw) = w; } }
            }
        } else {
            const int cb = (pn - 12) * 128 + cw;
#pragma unroll
            for (int ai = 0; ai < 2; ++ai)
#pragma unroll
                for (int m = 0; m < 4; ++m) { const int row = row0 + ai * HALF + m * 16; const float rs = rstd[row]; f32x4 r0, r1, b0, b1;
#pragma unroll
                    for (int j = 0; j < 4; ++j) {
                        { const float za = fminf(fmaxf(acc[ai][0][m][0][j] * rs, -30.f), 30.f), zb = fminf(fmaxf(acc[ai][1][m][0][j] * rs, -30.f), 30.f);
                          const float ea = 1.0f + __expf(-za), eb = 1.0f + __expf(-zb); b0[j] = __builtin_amdgcn_rcpf(eb); r0[j] = eb * __builtin_amdgcn_rcpf(ea); }
                        { const float za = fminf(fmaxf(acc[ai][0][m][1][j] * rs, -30.f), 30.f), zb = fminf(fmaxf(acc[ai][1][m][1][j] * rs, -30.f), 30.f);
                          const float ea = 1.0f + __expf(-za), eb = 1.0f + __expf(-zb); b1[j] = __builtin_amdgcn_rcpf(eb); r1[j] = eb * __builtin_amdgcn_rcpf(ea); } }
                    u32x4 w; w.x = pk_bf16(r0[0], r0[1]); w.y = pk_bf16(r0[2], r0[3]); w.z = pk_bf16(r1[0], r1[1]); w.w = pk_bf16(r1[2], r1[3]);
                    *(u32x4*)(RAT + (size_t)row * D + cb) = w;
                    w.x = pk_bf16(b0[0], b0[1]); w.y = pk_bf16(b0[2], b0[3]); w.z = pk_bf16(b1[0], b1[1]); w.w = pk_bf16(b1[2], b1[3]);
                    *(u32x4*)(GB + (size_t)row * D + cb) = w; }
        }
    }
};

struct EpiY {
    static constexpr bool PERM = true; static constexpr int MID = 8;
    const bf16_t* RAT; const bf16_t* GB; const float* bias; bf16_t* Y;
    __device__ __forceinline__ void mid(f32x4 (&acc)[2][2][4][2], const Unit& u, int wr, int wc, int fr, int fq) const {
        const int row0 = u.pm * BM + wr * 64 + fr, col0 = u.pn * BM + wc * 32 + 8 * fq;
#pragma unroll
        for (int bj = 0; bj < 2; ++bj) { const f32x4 b0 = *(const f32x4*)(bias + col0 + bj * HALF), b1 = *(const f32x4*)(bias + col0 + bj * HALF + 4);
#pragma unroll
            for (int ai = 0; ai < 2; ++ai)
#pragma unroll
                for (int m = 0; m < 4; ++m) { const int row = row0 + ai * HALF + m * 16; const u32x4 w = *(const u32x4*)(RAT + (size_t)row * D + col0 + bj * HALF);
                    acc[ai][bj][m][0] = (acc[ai][bj][m][0] + b0) * (f32x4){bf_lo(w.x), bf_hi(w.x), bf_lo(w.y), bf_hi(w.y)};
                    acc[ai][bj][m][1] = (acc[ai][bj][m][1] + b1) * (f32x4){bf_lo(w.z), bf_hi(w.z), bf_lo(w.w), bf_hi(w.w)};
                    if (m & 1) asm volatile("" ::: "memory"); } }
    }
    __device__ __forceinline__ void operator()(const f32x4 (&acc)[2][2][4][2], const Unit& u, int wr, int wc, int fr, int fq) const {
        const int row0 = u.pm * BM + wr * 64 + fr, col0 = u.pn * BM + wc * 32 + 8 * fq;
#pragma unroll
        for (int ai = 0; ai < 2; ++ai)
#pragma unroll
            for (int m = 0; m < 4; ++m) { const int row = row0 + ai * HALF + m * 16;
#pragma unroll
                for (int bj = 0; bj < 2; ++bj) { const u32x4 w = *(const u32x4*)(GB + (size_t)row * D + col0 + bj * HALF);
                    const f32x4 v0 = acc[ai][bj][m][0] * (f32x4){bf_lo(w.x), bf_hi(w.x), bf_lo(w.y), bf_hi(w.y)};
                    const f32x4 v1 = acc[ai][bj][m][1] * (f32x4){bf_lo(w.z), bf_hi(w.z), bf_lo(w.w), bf_hi(w.w)};
                    u32x4 o; o.x = pk_bf16(v0[0], v0[1]); o.y = pk_bf16(v0[2], v0[3]); o.z = pk_bf16(v1[0], v1[1]); o.w = pk_bf16(v1[2], v1[3]);
                    *(u32x4*)(Y + (size_t)row * D + col0 + bj * HALF) = o; }
                asm volatile("" ::: "memory"); }
    }
};

template <bool WITH_BF> struct EpiRes {
    static constexpr bool PERM = false; static constexpr int MID = 0;
    const float* base; float* out; bf16_t* xb; unsigned long long* ss;
    __device__ __forceinline__ void operator()(const f32x4 (&acc)[2][2][4][2], const Unit& u, int wr, int wc, int fr, int fq) const {
        const int row0 = u.pm * BM + wr * 64 + fr, col0 = u.pn * BM + wc * 32 + 4 * fq;
#pragma unroll
        for (int ai = 0; ai < 2; ++ai)
#pragma unroll
            for (int m = 0; m < 4; ++m) { const int row = row0 + ai * HALF + m * 16; const size_t off = (size_t)row * D + col0; float s = 0.f;
#pragma unroll
                for (int bj = 0; bj < 2; ++bj)
#pragma unroll
                    for (int n = 0; n < 2; ++n) { const size_t o2 = off + bj * HALF + n * 16; const f32x4 o = *(const f32x4*)(base + o2) + acc[ai][bj][m][n];
                        *(f32x4*)(out + o2) = o; s += (o[0] * o[0] + o[1] * o[1]) + (o[2] * o[2] + o[3] * o[3]);
                        if (WITH_BF) { u32x2 w; w.x = pk_bf16(o[0], o[1]); w.y = pk_bf16(o[2], o[3]); *(u32x2*)(xb + o2) = w; } }
                s += __shfl_xor(s, 16); s += __shfl_xor(s, 32);
                if (fq == 0) atomicAdd(ss + row, (unsigned long long)(s * SS_SCALE)); }
    }
};

struct EpiUp {
    static constexpr bool PERM = true; static constexpr int MID = 0;
    const unsigned long long* ss; bf16_t* H;
    __device__ __forceinline__ void operator()(const f32x4 (&acc)[2][2][4][2], const Unit& u, int wr, int wc, int fr, int fq) const {
        const int row0 = u.pm * BM + wr * 64 + fr, col0 = u.pn * BM + wc * 32 + 8 * fq;
#pragma unroll
        for (int ai = 0; ai < 2; ++ai)
#pragma unroll
            for (int m = 0; m < 4; ++m) { const int row = row0 + ai * HALF + m * 16; const float rs = rsqrtf((float)ss[row] * SS_INV + NORM_EPS);
#pragma unroll
                for (int bj = 0; bj < 2; ++bj) { f32x4 v0 = acc[ai][bj][m][0] * rs, v1 = acc[ai][bj][m][1] * rs;
#pragma unroll
                    for (int j = 0; j < 4; ++j) { v0[j] = fmaxf(v0[j], 0.f); v1[j] = fmaxf(v1[j], 0.f); }
                    v0 = v0 * v0; v1 = v1 * v1;
                    u32x4 o; o.x = pk_bf16(v0[0], v0[1]); o.y = pk_bf16(v0[2], v0[3]); o.z = pk_bf16(v1[0], v1[1]); o.w = pk_bf16(v1[2], v1[3]);
                    *(u32x4*)(H + (size_t)row * FF + col0 + bj * HALF) = o; } }
    }
};

struct Args { const float* in[17]; float* out; unsigned char* ws; int ph_lo, ph_hi; };

__device__ __forceinline__ void p0_transpose_item(const float* W, int N, bf16_t* WT, int ldk, int k_off, int drow0, const float* scale, LAS float* scr, int k0, int n0, int lane) {
#pragma unroll 8
    for (int i = 0; i < 32; ++i) { const int kk = 2 * i + (lane >> 5); float v = W[(size_t)(k0 + kk) * N + n0 + (lane & 31)]; if (scale) v *= scale[k0 + kk]; scr[kk * 33 + (lane & 31)] = v; }
    asm volatile("s_waitcnt lgkmcnt(0)" ::: "memory");
    const int c = lane & 7;
#pragma unroll
    for (int j = 0; j < 4; ++j) { const int n = (lane >> 3) + 8 * j; const LAS float* s = scr + (8 * c) * 33 + n;
        u32x4 o; o.x = pk_bf16(s[0 * 33], s[1 * 33]); o.y = pk_bf16(s[2 * 33], s[3 * 33]); o.z = pk_bf16(s[4 * 33], s[5 * 33]); o.w = pk_bf16(s[6 * 33], s[7 * 33]);
        *(u32x4*)(WT + (size_t)(drow0 + n) * ldk + k_off + k0 + 8 * c) = o; }
    asm volatile("s_waitcnt lgkmcnt(0)" ::: "memory");
}
__device__ __forceinline__ int win_dest_row(int n) {
    if (n < 512) return 256 * (n >> 7) + (n & 127);
    if (n < 1024) { const int q = n - 512; return 256 * (q >> 7) + 128 + (q & 127); }
    if (n < 3072) return n;
    if (n < 4096) { const int q = n - 3072; return 3072 + 256 * (q >> 7) + (q & 127); }
    const int q = n - 4096; return 3072 + 256 * (q >> 7) + 128 + (q & 127);
}

constexpr int CV_T = 32, CV_IN_ROWS = CV_T + CK - 1  , CV_OUT_OFF = CV_IN_ROWS * CW * 2  ;
__device__ __forceinline__ void conv_item(LAS unsigned char* lds, const bf16_t* U, const float* dw_w, const float* dw_b, const float* ln_w, const float* ln_b, bf16_t* YA, int item, int tid, int wave, int lane) {
    const int b = item >> 7, t0 = (item & 127) * CV_T; const size_t rowb = (size_t)b * SEQ;
    for (int i = tid; i < CV_IN_ROWS * 64; i += NTHR) { const int r = i >> 6, c = i & 63, tok = t0 - (CK - 1) + r;
        u32x4 v = (u32x4){0u, 0u, 0u, 0u}; if (tok >= 0) v = *(const u32x4*)(U + (rowb + tok) * CW + c * 8);
        *(LAS u32x4*)(lds + r * 1024 + c * 16) = v; }
    const int cp = tid & 255, th = tid >> 8, c0 = 2 * cp;
    f32x2 w[CK];
#pragma unroll
    for (int j = 0; j < CK; ++j) w[j] = *(const f32x2*)(dw_w + j * CW + c0);
    const f32x2 bias = *(const f32x2*)(dw_b + c0);
    __syncthreads();
    LAS float* OUT = (LAS float*)(lds + CV_OUT_OFF);
#pragma unroll 1
    for (int sb = 0; sb < 2; ++sb) { const int base = th * 16 + sb * 8;
        unsigned in[38];
#pragma unroll
        for (int r = 0; r < 38; ++r) in[r] = *(const LAS unsigned*)(lds + (base + r) * 1024 + cp * 4);
#pragma unroll
        for (int o = 0; o < 8; ++o) { float a0 = bias.x, a1 = bias.y;
#pragma unroll
            for (int j = 0; j < CK; ++j) { a0 += w[j].x * bf_lo(in[o + j]); a1 += w[j].y * bf_hi(in[o + j]); }
            *(LAS f32x2*)(OUT + (base + o) * CW + c0) = (f32x2){a0, a1}; } }
    __syncthreads();
    const f32x4 lw0 = *(const f32x4*)(ln_w + 4 * lane), lw1 = *(const f32x4*)(ln_w + 256 + 4 * lane), lb0 = *(const f32x4*)(ln_b + 4 * lane), lb1 = *(const f32x4*)(ln_b + 256 + 4 * lane);
#pragma unroll
    for (int tk = 0; tk < 4; ++tk) { const int tok = wave * 4 + tk;
        f32x4 v0 = *(const LAS f32x4*)(OUT + tok * CW + 4 * lane), v1 = *(const LAS f32x4*)(OUT + tok * CW + 256 + 4 * lane);
        const float mean = wave_sum((v0[0] + v0[1]) + (v0[2] + v0[3]) + (v1[0] + v1[1]) + (v1[2] + v1[3])) * (1.0f / CW);
        v0 = v0 - mean; v1 = v1 - mean;
        const float var = wave_sum((v0[0] * v0[0] + v0[1] * v0[1]) + (v0[2] * v0[2] + v0[3] * v0[3]) + (v1[0] * v1[0] + v1[1] * v1[1]) + (v1[2] * v1[2] + v1[3] * v1[3])) * (1.0f / CW);
        const float rstd = rsqrtf(var + LN_EPS);
        v0 = v0 * rstd * lw0 + lb0; v1 = v1 * rstd * lw1 + lb1;
#pragma unroll
        for (int j = 0; j < 4; ++j) { v0[j] = v0[j] * sigm(v0[j]); v1[j] = v1[j] * sigm(v1[j]); }
        bf16_t* o = YA + (rowb + t0 + tok) * D;
        u32x2 p; p.x = pk_bf16(v0[0], v0[1]); p.y = pk_bf16(v0[2], v0[3]); *(u32x2*)(o + 4 * lane) = p;
        p.x = pk_bf16(v1[0], v1[1]); p.y = pk_bf16(v1[2], v1[3]); *(u32x2*)(o + 256 + 4 * lane) = p; }
    __syncthreads();
}

constexpr int HG_PS = 0, HG_TS = 72  , HG_NS = 136  ;
constexpr int HA_KT = 4096, HA_VT = HA_KT + 128 * HG_TS * 2;
constexpr int HC_QN = 4096, HC_KN = HC_QN + 64 * HG_NS * 2, HC_VT = HC_KN + 64 * HG_NS * 2, HC_SSQ = HC_VT + 128 * HG_TS * 2;

__device__ __forceinline__ void hgrn_a_unit(LAS unsigned char* lds, const bf16_t* G, const bf16_t* V, float* ACH, float* DCH, int unit, int wave, int lane) {
    const int h = unit & 3; const size_t row0 = (size_t)(unit >> 2) * CH; const int ch = 2 * lane, tg = wave;
    LAS float* PS = (LAS float*)(lds + HG_PS);
    unsigned gw[8], vw[8];
#pragma unroll
    for (int i = 0; i < 8; ++i) { const size_t off = (row0 + tg * 8 + i) * HW + h * HD + ch; gw[i] = *(const unsigned*)(G + off); vw[i] = *(const unsigned*)(V + off); }
    float bl0[8], bl1[8]; float s0 = 0.f, s1 = 0.f;
#pragma unroll
    for (int i = 0; i < 8; ++i) { s0 += bf_lo(gw[i]); s1 += bf_hi(gw[i]); bl0[i] = s0; bl1[i] = s1; }
    *(LAS f32x2*)(PS + tg * HD + ch) = (f32x2){s0, s1};
    __syncthreads();
    float pre0 = 0.f, pre1 = 0.f, tot0 = 0.f, tot1 = 0.f;
#pragma unroll
    for (int j = 0; j < 8; ++j) { const f32x2 p = *(const LAS f32x2*)(PS + j * HD + ch); tot0 += p.x; tot1 += p.y; if (j < tg) { pre0 += p.x; pre1 += p.y; } }
    float k0[8], k1[8];
#pragma unroll
    for (int i = 0; i < 8; ++i) { k0[i] = (1.0f - __expf(bf_lo(gw[i]))) * __expf(tot0 - (pre0 + bl0[i])); k1[i] = (1.0f - __expf(bf_hi(gw[i]))) * __expf(tot1 - (pre1 + bl1[i])); }
    u32x4 w;
    w.x = pk_bf16(k0[0], k0[1]); w.y = pk_bf16(k0[2], k0[3]); w.z = pk_bf16(k0[4], k0[5]); w.w = pk_bf16(k0[6], k0[7]); *(LAS u32x4*)(lds + HA_KT + (ch * HG_TS + tg * 8) * 2) = w;
    w.x = pk_bf16(k1[0], k1[1]); w.y = pk_bf16(k1[2], k1[3]); w.z = pk_bf16(k1[4], k1[5]); w.w = pk_bf16(k1[6], k1[7]); *(LAS u32x4*)(lds + HA_KT + ((ch + 1) * HG_TS + tg * 8) * 2) = w;
    w.x = (vw[0] & 0xffffu) | (vw[1] << 16); w.y = (vw[2] & 0xffffu) | (vw[3] << 16); w.z = (vw[4] & 0xffffu) | (vw[5] << 16); w.w = (vw[6] & 0xffffu) | (vw[7] << 16); *(LAS u32x4*)(lds + HA_VT + (ch * HG_TS + tg * 8) * 2) = w;
    w.x = (vw[0] >> 16) | (vw[1] & 0xffff0000u); w.y = (vw[2] >> 16) | (vw[3] & 0xffff0000u); w.z = (vw[4] >> 16) | (vw[5] & 0xffff0000u); w.w = (vw[6] >> 16) | (vw[7] & 0xffff0000u); *(LAS u32x4*)(lds + HA_VT + ((ch + 1) * HG_TS + tg * 8) * 2) = w;
    if (tg == 0) *(f32x2*)(DCH + (size_t)unit * HD + ch) = (f32x2){__expf(tot0), __expf(tot1)};
    __syncthreads();
    const int i16 = lane & 15, kq = lane >> 4;
    bf16x8 af[2];
#pragma unroll
    for (int ks = 0; ks < 2; ++ks) af[ks] = *(const LAS bf16x8*)(lds + HA_KT + ((16 * wave + i16) * HG_TS + 32 * ks + 8 * kq) * 2);
    float* dst = ACH + (size_t)unit * (HD * HD) + 16 * wave + 4 * kq;
#pragma unroll
    for (int dvt = 0; dvt < 8; ++dvt) { f32x4 acc = (f32x4){0.f, 0.f, 0.f, 0.f};
#pragma unroll
        for (int ks = 0; ks < 2; ++ks) { const bf16x8 bfr = *(const LAS bf16x8*)(lds + HA_VT + ((16 * dvt + i16) * HG_TS + 32 * ks + 8 * kq) * 2); acc = __builtin_amdgcn_mfma_f32_16x16x32_bf16(af[ks], bfr, acc, 0, 0, 0); }
        *(f32x4*)(dst + (16 * dvt + i16) * HD) = acc; }
    __syncthreads();
}

__device__ __forceinline__ void hgrn_b_scan(const float* ACH, const float* DCH, bf16_t* SCH, int gtid, int gsz) {
    for (int item = gtid; item < BATCH * NH * (HD * HD / 4); item += gsz) {
        const int bh = item >> 12, e4 = item & 4095, b = bh >> 2, h = bh & 3, dk4 = (e4 & 31) * 4;
        f32x4 S = (f32x4){0.f, 0.f, 0.f, 0.f};
#pragma unroll 8
        for (int c = 0; c < NCH; ++c) { const size_t unit = (size_t)((b * NCH + c) * NH + h);
            u32x2 w; w.x = pk_bf16(S[0], S[1]); w.y = pk_bf16(S[2], S[3]); *(u32x2*)(SCH + unit * (HD * HD) + e4 * 4) = w;
            const f32x4 a = *(const f32x4*)(ACH + unit * (HD * HD) + e4 * 4), d = *(const f32x4*)(DCH + unit * HD + dk4);
            S = d * S + a; }
    }
}

__device__ __forceinline__ void hgrn_c_unit(LAS unsigned char* lds, const bf16_t* Q, const bf16_t* G, const bf16_t* V, const bf16_t* SG, const bf16_t* SCH, const float* norm_w, bf16_t* YA, int unit, int wave, int lane) {
    const int h = unit & 3; const size_t row0 = (size_t)(unit >> 2) * CH; const int ch = 2 * lane, tg = wave;
    LAS float* PS = (LAS float*)(lds + HG_PS);
    unsigned gw[8], qw[8], vw[8];
#pragma unroll
    for (int i = 0; i < 8; ++i) { const size_t off = (row0 + tg * 8 + i) * HW + h * HD + ch; gw[i] = *(const unsigned*)(G + off); qw[i] = *(const unsigned*)(Q + off); vw[i] = *(const unsigned*)(V + off); }
    float bl0[8], bl1[8]; float s0 = 0.f, s1 = 0.f;
#pragma unroll
    for (int i = 0; i < 8; ++i) { s0 += bf_lo(gw[i]); s1 += bf_hi(gw[i]); bl0[i] = s0; bl1[i] = s1; }
    *(LAS f32x2*)(PS + tg * HD + ch) = (f32x2){s0, s1};
    __syncthreads();
    float pre0 = 0.f, pre1 = 0.f;
#pragma unroll
    for (int j = 0; j < 7; ++j) { const f32x2 p = *(const LAS f32x2*)(PS + j * HD + ch); if (j < tg) { pre0 += p.x; pre1 += p.y; } }
#pragma unroll
    for (int i = 0; i < 8; ++i) { const float b0 = pre0 + bl0[i], b1 = pre1 + bl1[i];
        const unsigned qn = pk_bf16(bf_lo(qw[i]) * __expf(b0), bf_hi(qw[i]) * __expf(b1));
        const unsigned kn = pk_bf16((1.0f - __expf(bf_lo(gw[i]))) * __expf(-b0), (1.0f - __expf(bf_hi(gw[i]))) * __expf(-b1));
        *(LAS unsigned*)(lds + HC_QN + ((tg * 8 + i) * HG_NS + ch) * 2) = qn; *(LAS unsigned*)(lds + HC_KN + ((tg * 8 + i) * HG_NS + ch) * 2) = kn; }
    u32x4 w;
    w.x = (vw[0] & 0xffffu) | (vw[1] << 16); w.y = (vw[2] & 0xffffu) | (vw[3] << 16); w.z = (vw[4] & 0xffffu) | (vw[5] << 16); w.w = (vw[6] & 0xffffu) | (vw[7] << 16); *(LAS u32x4*)(lds + HC_VT + (ch * HG_TS + tg * 8) * 2) = w;
    w.x = (vw[0] >> 16) | (vw[1] & 0xffff0000u); w.y = (vw[2] >> 16) | (vw[3] & 0xffff0000u); w.z = (vw[4] >> 16) | (vw[5] & 0xffff0000u); w.w = (vw[6] >> 16) | (vw[7] & 0xffff0000u); *(LAS u32x4*)(lds + HC_VT + ((ch + 1) * HG_TS + tg * 8) * 2) = w;
    __syncthreads();
    const int i16 = lane & 15, kq = lane >> 4, tt = wave >> 1, dh = wave & 1;
    bf16x8 qf[4];
#pragma unroll
    for (int ks = 0; ks < 4; ++ks) qf[ks] = *(const LAS bf16x8*)(lds + HC_QN + ((16 * tt + i16) * HG_NS + 32 * ks + 8 * kq) * 2);
    f32x4 pt[4];
#pragma unroll
    for (int st = 0; st < 4; ++st) { pt[st] = (f32x4){0.f, 0.f, 0.f, 0.f};
        if (st <= tt) {
#pragma unroll
            for (int ks = 0; ks < 4; ++ks) { const bf16x8 kf = *(const LAS bf16x8*)(lds + HC_KN + ((16 * st + i16) * HG_NS + 32 * ks + 8 * kq) * 2); pt[st] = __builtin_amdgcn_mfma_f32_16x16x32_bf16(kf, qf[ks], pt[st], 0, 0, 0); }
            if (st == tt) {
#pragma unroll
                for (int r = 0; r < 4; ++r) if (4 * kq + r > i16) pt[st][r] = 0.f; } } }
    bf16x8 pf[2];
#pragma unroll
    for (int p = 0; p < 2; ++p) { u32x4 t; t.x = pk_bf16(pt[2 * p][0], pt[2 * p][1]); t.y = pk_bf16(pt[2 * p][2], pt[2 * p][3]); t.z = pk_bf16(pt[2 * p + 1][0], pt[2 * p + 1][1]); t.w = pk_bf16(pt[2 * p + 1][2], pt[2 * p + 1][3]); pf[p] = __builtin_bit_cast(bf16x8, t); }
    f32x4 o[4]; float ssq = 0.f;
    const bf16_t* Su = SCH + (size_t)unit * (HD * HD);
#pragma unroll
    for (int dvt = 0; dvt < 4; ++dvt) { const int dv0 = 16 * (4 * dh + dvt); f32x4 acc = (f32x4){0.f, 0.f, 0.f, 0.f};
#pragma unroll
        for (int ks = 0; ks < 4; ++ks) { const bf16x8 sf = *(const bf16x8*)(Su + (dv0 + i16) * HD + 32 * ks + 8 * kq); acc = __builtin_amdgcn_mfma_f32_16x16x32_bf16(sf, qf[ks], acc, 0, 0, 0); }
#pragma unroll
        for (int p = 0; p < 2; ++p) if (2 * p <= tt) { const u32x2 lo = *(const LAS u32x2*)(lds + HC_VT + ((dv0 + i16) * HG_TS + 32 * p + 4 * kq) * 2), hi = *(const LAS u32x2*)(lds + HC_VT + ((dv0 + i16) * HG_TS + 32 * p + 16 + 4 * kq) * 2);
            const u32x4 t = (u32x4){lo.x, lo.y, hi.x, hi.y}; acc = __builtin_amdgcn_mfma_f32_16x16x32_bf16(__builtin_bit_cast(bf16x8, t), pf[p], acc, 0, 0, 0); }
        o[dvt] = acc; ssq += (acc[0] * acc[0] + acc[1] * acc[1]) + (acc[2] * acc[2] + acc[3] * acc[3]); }
    ssq += __shfl_xor(ssq, 16); ssq += __shfl_xor(ssq, 32);
    LAS float* SSQ = (LAS float*)(lds + HC_SSQ);
    if (kq == 0) SSQ[dh * 64 + 16 * tt + i16] = ssq;
    __syncthreads();
    const float rstd = rsqrtf((SSQ[16 * tt + i16] + SSQ[64 + 16 * tt + i16]) * (1.0f / HD) + NORM_EPS);
    const size_t row = row0 + 16 * tt + i16;
#pragma unroll
    for (int dvt = 0; dvt < 4; ++dvt) { const int col = h * HD + 16 * (4 * dh + dvt) + 4 * kq;
        const f32x4 nw = *(const f32x4*)(norm_w + col); const u32x2 sg = *(const u32x2*)(SG + row * HW + col);
        const f32x4 v = o[dvt] * rstd * nw * (f32x4){bf_lo(sg.x), bf_hi(sg.x), bf_lo(sg.y), bf_hi(sg.y)};
        u32x2 p; p.x = pk_bf16(v[0], v[1]); p.y = pk_bf16(v[2], v[3]); *(u32x2*)(YA + row * D + CW + col) = p; }
    __syncthreads();
}

__global__ void __launch_bounds__(NTHR, 2) mk_fwd(Args args) {
    extern __shared__ __attribute__((aligned(16))) unsigned char lds_raw[];
    LAS unsigned char* lds = (LAS unsigned char*)lds_raw;
    const int tid = threadIdx.x, lane = tid & 63, wave = __builtin_amdgcn_readfirstlane(tid >> 6);
    const int G = gridDim.x, bx = blockIdx.x;
    unsigned char* ws = args.ws;
    const float* x = args.in[0];
    float* out = args.out;
    const int lo = args.ph_lo, hi = args.ph_hi;
#ifndef PH_MASK
#define PH_MASK 0x3ff
#endif
#define IN(k) (((PH_MASK >> (k)) & 1) && lo <= (k) && (k) < hi)
#define SEAM(k) do { if (IN(k) && IN((k) + 1)) { cg::this_grid().sync(); } } while (0)

    if (IN(0)) {
        const int gw = bx * NWAVES + wave, NGW = G * NWAVES;
        { unsigned long long* z = (unsigned long long*)(ws + WS_SS2); for (int i = bx * NTHR + tid; i < 2 * M; i += G * NTHR) z[i] = 0ull; }
        LAS float* scr = (LAS float*)(lds + wave * 16384);
        constexpr int I_IN = (D / 64) * (INC / 32), I_PW = (CW / 64) * (D / 32), I_HO = I_PW, I_O = (D / 64) * (D / 32), I_UP = (D / 64) * (FF / 32), I_DN = (FF / 64) * (D / 32);
        constexpr int NITEMS = I_IN + I_PW + I_HO + I_O + I_UP + I_DN;
        for (int it = gw; it < NITEMS; it += NGW) {
            int r = it;
            if (r < I_IN) { const int nb = INC / 32, k0 = 64 * (r / nb), n0 = 32 * (r % nb); p0_transpose_item(args.in[2], INC, (bf16_t*)(ws + WS_WIN), D, 0, win_dest_row(n0), args.in[1], scr, k0, n0, lane); continue; } r -= I_IN;
            if (r < I_PW) { const int nb = D / 32, k0 = 64 * (r / nb), n0 = 32 * (r % nb); p0_transpose_item(args.in[7], D, (bf16_t*)(ws + WS_WCAT), D, 0, n0, nullptr, scr, k0, n0, lane); continue; } r -= I_PW;
            if (r < I_HO) { const int nb = D / 32, k0 = 64 * (r / nb), n0 = 32 * (r % nb); p0_transpose_item(args.in[11], D, (bf16_t*)(ws + WS_WCAT), D, CW, n0, nullptr, scr, k0, n0, lane); continue; } r -= I_HO;
            if (r < I_O) { const int nb = D / 32, k0 = 64 * (r / nb), n0 = 32 * (r % nb); p0_transpose_item(args.in[12], D, (bf16_t*)(ws + WS_WOUT), D, 0, n0, nullptr, scr, k0, n0, lane); continue; } r -= I_O;
            if (r < I_UP) { const int nb = FF / 32, k0 = 64 * (r / nb), n0 = 32 * (r % nb); p0_transpose_item(args.in[14], FF, (bf16_t*)(ws + WS_WUP), D, 0, n0, args.in[13], scr, k0, n0, lane); continue; } r -= I_UP;
            { const int nb = D / 32, k0 = 64 * (r / nb), n0 = 32 * (r % nb); p0_transpose_item(args.in[15], D, (bf16_t*)(ws + WS_WDN), FF, 0, n0, nullptr, scr, k0, n0, lane); }
        }
        bf16_t* XB = (bf16_t*)(ws + WS_XB); float* RS = (float*)(ws + WS_RSTD1);
        for (int m = gw; m < M; m += NGW) { const f32x4* xr = (const f32x4*)(x + (size_t)m * D) + lane; f32x4 v[4]; float s = 0.f;
#pragma unroll
            for (int j = 0; j < 4; ++j) { v[j] = xr[64 * j]; s += (v[j][0] * v[j][0] + v[j][1] * v[j][1]) + (v[j][2] * v[j][2] + v[j][3] * v[j][3]); }
            s = wave_sum(s); if (lane == 0) RS[m] = rsqrtf(s * (1.0f / D) + NORM_EPS);
            u32x2* o8 = (u32x2*)(XB + (size_t)m * D) + lane;
#pragma unroll
            for (int j = 0; j < 4; ++j) { u32x2 p; p.x = pk_bf16(v[j][0], v[j][1]); p.y = pk_bf16(v[j][2], v[j][3]); o8[64 * j] = p; } }
        __syncthreads();
    }
    SEAM(0);
    if (IN(1)) {
        pg8::Gemm g{(const bf16_t*)(ws + WS_XB), (const bf16_t*)(ws + WS_WIN), M, INC, D}; pg8::StaticOrder S; S.init(M, INC, G, bx);
        EpiProj E{(const float*)(ws + WS_RSTD1), args.in[9], (bf16_t*)(ws + WS_U), (bf16_t*)(ws + WS_Q), (bf16_t*)(ws + WS_G), (bf16_t*)(ws + WS_V), (bf16_t*)(ws + WS_SG), (bf16_t*)(ws + WS_RAT), (bf16_t*)(ws + WS_GB)};
        pg8::gemm_phase<EpiProj>(lds, g, S, E);
    }
    SEAM(1);
    if (IN(2)) {
        for (int it = bx; it < M / CV_T; it += G) conv_item(lds, (const bf16_t*)(ws + WS_U), args.in[3], args.in[4], args.in[5], args.in[6], (bf16_t*)(ws + WS_YA), it, tid, wave, lane);
        for (int it = bx; it < NUNIT; it += G) hgrn_a_unit(lds, (const bf16_t*)(ws + WS_G), (const bf16_t*)(ws + WS_V), out, (float*)(ws + WS_DCH), it, wave, lane);
    }
    SEAM(2);
    if (IN(3)) hgrn_b_scan(out, (const float*)(ws + WS_DCH), (bf16_t*)(ws + WS_SCH), bx * NTHR + tid, G * NTHR);
    SEAM(3);
    if (IN(4)) {
        for (int it = bx; it < NUNIT; it += G) hgrn_c_unit(lds, (const bf16_t*)(ws + WS_Q), (const bf16_t*)(ws + WS_G), (const bf16_t*)(ws + WS_V), (const bf16_t*)(ws + WS_SG), (const bf16_t*)(ws + WS_SCH), args.in[10], (bf16_t*)(ws + WS_YA), it, wave, lane);
    }
    SEAM(4);
    if (IN(5)) {
        pg8::Gemm g{(const bf16_t*)(ws + WS_YA), (const bf16_t*)(ws + WS_WCAT), M, D, D}; pg8::StaticOrder S; S.init(M, D, G, bx);
        EpiY E{(const bf16_t*)(ws + WS_RAT), (const bf16_t*)(ws + WS_GB), args.in[8], (bf16_t*)(ws + WS_Y)};
        pg8::gemm_phase<EpiY>(lds, g, S, E);
    }
    SEAM(5);
    if (IN(6)) {
        pg8::Gemm g{(const bf16_t*)(ws + WS_Y), (const bf16_t*)(ws + WS_WOUT), M, D, D}; pg8::StaticOrder S; S.init(M, D, G, bx);
        EpiRes<true> E{x, out, (bf16_t*)(ws + WS_X1B), (unsigned long long*)(ws + WS_SS2)};
        pg8::gemm_phase<EpiRes<true>>(lds, g, S, E);
    }
    SEAM(6);
    if (IN(7)) {
        pg8::Gemm g{(const bf16_t*)(ws + WS_X1B), (const bf16_t*)(ws + WS_WUP), M, FF, D}; pg8::StaticOrder S; S.init(M, FF, G, bx);
        EpiUp E{(const unsigned long long*)(ws + WS_SS2), (bf16_t*)(ws + WS_HID)};
        pg8::gemm_phase<EpiUp>(lds, g, S, E);
    }
    SEAM(7);
    if (IN(8)) {
        pg8::Gemm g{(const bf16_t*)(ws + WS_HID), (const bf16_t*)(ws + WS_WDN), M, D, FF}; pg8::StaticOrder S; S.init(M, D, G, bx);
        EpiRes<false> E{out, out, nullptr, (unsigned long long*)(ws + WS_SS3)};
        pg8::gemm_phase<EpiRes<false>>(lds, g, S, E);
    }
    SEAM(8);
    if (IN(9)) {
        const int gw = bx * NWAVES + wave, NGW = G * NWAVES; const unsigned long long* ss = (const unsigned long long*)(ws + WS_SS3); const float* wf = args.in[16];
        f32x4 wv[4];
#pragma unroll
        for (int j = 0; j < 4; ++j) wv[j] = *((const f32x4*)wf + lane + 64 * j);
        for (int m = gw; m < M; m += NGW) { f32x4* xr = (f32x4*)(out + (size_t)m * D) + lane; const float rs = rsqrtf((float)ss[m] * SS_INV + NORM_EPS);
#pragma unroll
            for (int j = 0; j < 4; ++j) xr[64 * j] = xr[64 * j] * rs * wv[j]; }
    }
#undef IN
#undef SEAM
}

extern "C" void kernel_launch(void* const* d_in, const int* in_sizes, int n_in, void* d_out, int out_size, void* d_ws, size_t ws_size, hipStream_t stream) {
    static int grid = 0;
    if (grid == 0) {
        if (n_in != 17 || in_sizes[0] != M * D || out_size != M * D || ws_size < WS_END) { fprintf(stderr, "kernel_launch: unexpected shapes (n_in %d, in0 %d, out %d, ws %zu)\n", n_in, n_in > 0 ? in_sizes[0] : -1, out_size, ws_size); grid = -1; return; }
        int dev = 0, cus = 0, per_cu = 0;
        if (hipGetDevice(&dev) != hipSuccess || hipDeviceGetAttribute(&cus, hipDeviceAttributeMultiprocessorCount, dev) != hipSuccess) { grid = -1; return; }
        if (hipFuncSetAttribute((const void*)mk_fwd, hipFuncAttributeMaxDynamicSharedMemorySize, LDS_BYTES) != hipSuccess) { fprintf(stderr, "kernel_launch: hipFuncSetAttribute failed\n"); grid = -1; return; }
        if (hipOccupancyMaxActiveBlocksPerMultiprocessor(&per_cu, (const void*)mk_fwd, NTHR, LDS_BYTES) != hipSuccess || per_cu < 1) { fprintf(stderr, "kernel_launch: occupancy query gave %d\n", per_cu); per_cu = 1; }
        (void)hipGetLastError();
        grid = cus * per_cu;
    }
    if (grid < 0) return;
    Args a{};
    for (int i = 0; i < 17; ++i) a.in[i] = (const float*)d_in[i];
    a.out = (float*)d_out; a.ws = (unsigned char*)d_ws;
#if MK_N_LAUNCHES == 1
    a.ph_lo = 0; a.ph_hi = 10;
    void* kargs[] = {&a};
    hipError_t e = hipLaunchCooperativeKernel((const void*)mk_fwd, dim3(grid), dim3(NTHR), kargs, LDS_BYTES, stream);
    if (e != hipSuccess) fprintf(stderr, "cooperative launch failed: %s (grid %d)\n", hipGetErrorString(e), grid);
#else
    for (int p = 0; p < 10; ++p) { a.ph_lo = p; a.ph_hi = p + 1; hipLaunchKernelGGL(mk_fwd, dim3(grid), dim3(NTHR), LDS_BYTES, stream, a); }
#endif
}
```

```cpp
#include <hip/hip_runtime.h>
#include <hip/hip_cooperative_groups.h>
#include <cstdio>
#include <cstdint>
namespace cg = cooperative_groups;

#ifndef MK_N_LAUNCHES
#define MK_N_LAUNCHES 1
#endif

#define LAS __attribute__((address_space(3)))
typedef unsigned short bf16_t;
typedef short bf16x8 __attribute__((ext_vector_type(8)));
typedef float f32x4 __attribute__((ext_vector_type(4)));
typedef float f32x2 __attribute__((ext_vector_type(2)));
typedef unsigned u32x4 __attribute__((ext_vector_type(4)));
typedef unsigned u32x2 __attribute__((ext_vector_type(2)));
typedef __bf16 bf16x2v __attribute__((ext_vector_type(2)));

__device__ __forceinline__ unsigned pk_bf16(float lo, float hi) { f32x2 v = {lo, hi}; bf16x2v b = __builtin_convertvector(v, bf16x2v); return __builtin_bit_cast(unsigned, b); }
__device__ __forceinline__ float bf_lo(unsigned w) { return __uint_as_float(w << 16); }
__device__ __forceinline__ float bf_hi(unsigned w) { return __uint_as_float(w & 0xffff0000u); }
__device__ __forceinline__ float sigm(float x) { return __builtin_amdgcn_rcpf(1.0f + __expf(-x)); }
__device__ __forceinline__ float wave_sum(float v) {
#pragma unroll
    for (int o = 1; o < 64; o <<= 1) v += __shfl_xor(v, o);
    return v;
}

namespace pg8 {
#define PG8_LAS __attribute__((address_space(3)))
constexpr int BM = 256, BK = 64, HALF = 128, HTB = HALF * BK * 2, STAGE_BYTES = 8 * HTB, NXCD = 8, WGM = 8;
__host__ __device__ __forceinline__ int lds_byte(int r, int c) { const int st = (r >> 4) * 2 + (c >> 5), rr = r & 15, cc = c & 31, ob = rr * 64 + cc * 2; return st * 1024 + (ob ^ (((ob >> 9) & 1) << 5)); }
__host__ __device__ __forceinline__ void stage_rc(int b, int& R, int& C) { const int st = b / 1024, sb = b % 1024, swz = sb ^ (((sb >> 9) & 1) << 5); R = (st >> 1) * 16 + swz / 64; C = (st & 1) * 32 + (swz % 64) / 2; }
__host__ __device__ __forceinline__ int perm32(int rho) { const int n = rho >> 4, i = rho & 15; return 8 * (i >> 2) + 4 * n + (i & 3); }

struct Unit { int pm, pn; };
struct Gemm { const bf16_t* A; const bf16_t* Bt; int M, N, K; };

struct StaticOrder {
    int nM, nN, nwg, G, c;
    __host__ __device__ void init(int M, int N, int G_, int c_) { nM = M / BM; nN = N / BM; nwg = nM * nN; G = G_; c = c_; }
    __host__ __device__ bool next(int i, Unit& u) const {
        const long L = (long)i * G + c; if (L >= nwg) return false;
        int wgid = (int)L; { const int q = nwg / NXCD, r = nwg % NXCD, xcd = wgid % NXCD, off = wgid / NXCD; wgid = (xcd < r ? xcd * (q + 1) : r * (q + 1) + (xcd - r) * q) + off; }
        const int nig = WGM * nN, gid = wgid / nig, fm = gid * WGM, gsz = (nM - fm) < WGM ? (nM - fm) : WGM;
        u.pm = fm + ((wgid % nig) % gsz); u.pn = (wgid % nig) / gsz; return true;
    }
};

template <class Epi, bool ALIGN_EPI = true>
__device__ __forceinline__ void gemm_phase(PG8_LAS unsigned char* lds, const Gemm g, const StaticOrder& S, const Epi& E) {
    const int tid = threadIdx.x, wid = __builtin_amdgcn_readfirstlane(tid >> 6), lane = tid & 63, wr = wid >> 2, wc = wid & 3, fr = lane & 15, fq = lane >> 4;
    const int K = g.K, nt = K / BK;
    unsigned voffA[2], voffB[2];
#pragma unroll
    for (int i = 0; i < 2; ++i) { int R, C; stage_rc(tid * 16 + i * 8192, R, C); const int Rb = Epi::PERM ? ((R & ~31) + perm32(R & 31)) : R;
        voffA[i] = (unsigned)(R * K + C) * 2u; voffB[i] = (unsigned)(Rb * K + C) * 2u; }
    const size_t kstep = (size_t)(BK * 2);
    const size_t hstep = (size_t)HALF * K * 2;
    const size_t tstep = 2 * hstep;
    const unsigned ldsw = (unsigned)wid * 1024u;
    const int aoff = lds_byte(wr * 64 + fr, fq * 8), boff = lds_byte(wc * 32 + fr, fq * 8);
#define PG8_SA(b, h) (((b) * 2 + (h)) * HTB)
#define PG8_SB(b, h) ((4 + (b) * 2 + (h)) * HTB)
#define PG8_STAGE(bufoff, gbase, voff) do { _Pragma("unroll") for (int _i = 0; _i < 2; ++_i) \
        __builtin_amdgcn_global_load_lds((const unsigned*)((const char*)(gbase) + (voff)[_i]), (PG8_LAS unsigned*)(lds + (bufoff) + ldsw + _i * 8192), 16, 0, 0); } while (0)
#define PG8_LDA(dst, b, h) do { _Pragma("unroll") for (int m = 0; m < 4; ++m) _Pragma("unroll") for (int k = 0; k < 2; ++k) dst[m][k] = *(const PG8_LAS bf16x8*)(lds + PG8_SA(b, h) + aoff + m * 2048 + k * 1024); } while (0)
#define PG8_LDB(dst, b, h) do { _Pragma("unroll") for (int n = 0; n < 2; ++n) _Pragma("unroll") for (int k = 0; k < 2; ++k) dst[n][k] = *(const PG8_LAS bf16x8*)(lds + PG8_SB(b, h) + boff + n * 2048 + k * 1024); } while (0)
#define PG8_MMA(ai, bj, At, Bt) do { __builtin_amdgcn_s_setprio(1); _Pragma("unroll") for (int m = 0; m < 4; ++m) _Pragma("unroll") for (int n = 0; n < 2; ++n) _Pragma("unroll") for (int k = 0; k < 2; ++k) \
        acc[ai][bj][m][n] = __builtin_amdgcn_mfma_f32_16x16x32_bf16(Bt[n][k], At[m][k], acc[ai][bj][m][n], 0, 0, 0); __builtin_amdgcn_s_setprio(0); } while (0)
#define PG8_WAIT_V(n) asm volatile("s_waitcnt vmcnt(" #n ")" ::: "memory")
#define PG8_WAIT_L(n) asm volatile("s_waitcnt lgkmcnt(" #n ")" ::: "memory")
#define PG8_BAR __builtin_amdgcn_s_barrier()
#define PG8_SCHED __builtin_amdgcn_sched_barrier(0)
    Unit cur, nxt; int ui = 0;
    if (!S.next(0, cur)) return;
    f32x4 acc[2][2][4][2];
#pragma unroll
    for (int a = 0; a < 2; ++a)
#pragma unroll
        for (int b = 0; b < 2; ++b)
#pragma unroll
            for (int m = 0; m < 4; ++m)
#pragma unroll
                for (int n = 0; n < 2; ++n) acc[a][b][m][n] = (f32x4){0.f, 0.f, 0.f, 0.f};
    bf16x8 At[4][2], B0[2][2], B1[2][2];
    const char* cA = (const char*)g.A + (size_t)cur.pm * tstep; const char* cB = (const char*)g.Bt + (size_t)cur.pn * tstep;
    PG8_STAGE(PG8_SB(0, 0), cB, voffB); PG8_STAGE(PG8_SB(0, 1), cB + hstep, voffB); PG8_STAGE(PG8_SA(0, 0), cA, voffA); PG8_STAGE(PG8_SA(0, 1), cA + hstep, voffA);
    if (wr == 1) PG8_BAR;
    PG8_WAIT_V(2); PG8_BAR;
    PG8_STAGE(PG8_SB(1, 0), cB + kstep, voffB); PG8_STAGE(PG8_SA(1, 0), cA + kstep, voffA); PG8_STAGE(PG8_SB(1, 1), cB + hstep + kstep, voffB);
    PG8_WAIT_V(6); PG8_BAR;
    for (;;) {
        const bool has_next = S.next(ui + 1, nxt);
        const char* nA = has_next ? (const char*)g.A + (size_t)nxt.pm * tstep : cA; const char* nB = has_next ? (const char*)g.Bt + (size_t)nxt.pn * tstep : cB;
        for (int t = 0; t < nt; t += 2) {
            const bool last = (t == nt - 2);
            const char* a1 = cA + (size_t)(t + 1) * kstep;
            const char* a2 = last ? nA : cA + (size_t)(t + 2) * kstep; const char* b2 = last ? nB : cB + (size_t)(t + 2) * kstep;
            const char* a3 = a2 + kstep; const char* b3 = b2 + kstep;
            PG8_LDB(B0, 0, 0); PG8_LDB(B1, 0, 1); PG8_SCHED; PG8_LDA(At, 0, 0); PG8_STAGE(PG8_SA(1, 1), a1 + hstep, voffA);
            PG8_WAIT_V(8); PG8_WAIT_L(0); PG8_BAR; PG8_MMA(0, 0, At, B0); PG8_MMA(0, 1, At, B1); PG8_BAR; PG8_SCHED;
            PG8_LDA(At, 0, 1); PG8_STAGE(PG8_SB(0, 0), b2, voffB); PG8_STAGE(PG8_SB(0, 1), b2 + hstep, voffB); PG8_STAGE(PG8_SA(0, 0), a2, voffA);
            PG8_WAIT_V(8); PG8_WAIT_L(0); PG8_BAR; PG8_MMA(1, 0, At, B0); PG8_MMA(1, 1, At, B1); PG8_BAR; PG8_SCHED;
            PG8_LDB(B0, 1, 0); PG8_LDB(B1, 1, 1); PG8_SCHED; PG8_LDA(At, 1, 0); PG8_STAGE(PG8_SA(0, 1), a2 + hstep, voffA);
            PG8_WAIT_V(8); PG8_WAIT_L(0); PG8_BAR; PG8_MMA(0, 0, At, B0); PG8_MMA(0, 1, At, B1); PG8_BAR; PG8_SCHED;
            PG8_LDA(At, 1, 1); PG8_STAGE(PG8_SB(1, 0), b3, voffB); PG8_STAGE(PG8_SB(1, 1), b3 + hstep, voffB); PG8_STAGE(PG8_SA(1, 0), a3, voffA);
            PG8_WAIT_V(8); PG8_WAIT_L(0); PG8_BAR; PG8_MMA(1, 0, At, B0); PG8_MMA(1, 1, At, B1); PG8_BAR; PG8_SCHED;
            if constexpr (Epi::MID > 0) { if (t + 2 == Epi::MID) { int fr_ = fr, fq_ = fq; asm volatile("" : "+v"(fr_), "+v"(fq_)); E.mid(acc, cur, wr, wc, fr_, fq_); } }
        }
        if constexpr (ALIGN_EPI) { if (wr == 0) PG8_BAR; }
        { int fr_ = fr, fq_ = fq; asm volatile("" : "+v"(fr_), "+v"(fq_)); E(acc, cur, wr, wc, fr_, fq_); }
        if (!has_next) break;
#pragma unroll
        for (int a = 0; a < 2; ++a)
#pragma unroll
            for (int b = 0; b < 2; ++b)
#pragma unroll
                for (int m = 0; m < 4; ++m)
#pragma unroll
                    for (int n = 0; n < 2; ++n) acc[a][b][m][n] = (f32x4){0.f, 0.f, 0.f, 0.f};
        cur = nxt; cA = nA; cB = nB; ++ui;
        if constexpr (ALIGN_EPI) { if (wr == 1) PG8_BAR; }
    }
    PG8_WAIT_V(0);
    if constexpr (!ALIGN_EPI) { if (wr == 0) PG8_BAR; }
    PG8_BAR;
#undef PG8_SA
#undef PG8_SB
#undef PG8_STAGE
#undef PG8_LDA
#undef PG8_LDB
#undef PG8_MMA
#undef PG8_WAIT_V
#undef PG8_WAIT_L
#undef PG8_BAR
#undef PG8_SCHED
}
}

constexpr int NWAVES = 8, NTHR = 512;
constexpr int BATCH = 8, SEQ = 4096, D = 1024, M = BATCH * SEQ;
constexpr int CW = 512, HW = 512, HD = 128, NH = 4, FF = 4096, CK = 31, CH = 64, NCH = SEQ / CH;
constexpr int INC = 5120;
constexpr int NUNIT = BATCH * NCH * NH;
constexpr float NORM_EPS = 1e-6f, LN_EPS = 1e-5f;
constexpr float SS_SCALE = 16777216.0f, SS_INV = 1.0f / (16777216.0f * 1024.0f);

constexpr size_t MiB = 1u << 20;
constexpr size_t WS_RSTD1 = 1 * MiB;
constexpr size_t WS_SS2 = 1 * MiB + 256 * 1024;
constexpr size_t WS_SS3 = 1 * MiB + 512 * 1024;
constexpr size_t WS_DCH = 2 * MiB;
constexpr size_t WS_WIN = 4 * MiB;
constexpr size_t WS_WCAT = 14 * MiB;
constexpr size_t WS_WOUT = 16 * MiB;
constexpr size_t WS_WUP = 18 * MiB;
constexpr size_t WS_WDN = 26 * MiB;
constexpr size_t WS_XB = 34 * MiB;
constexpr size_t WS_SCH = WS_XB, WS_X1B = WS_XB;
constexpr size_t WS_U = 98 * MiB;
constexpr size_t WS_Q = 130 * MiB, WS_G = 162 * MiB, WS_V = 194 * MiB, WS_SG = 226 * MiB;
constexpr size_t WS_RAT = 258 * MiB, WS_GB = 322 * MiB;
constexpr size_t WS_YA = 386 * MiB;
constexpr size_t WS_Y = 98 * MiB;
constexpr size_t WS_HID = 98 * MiB;
constexpr size_t WS_END = 450 * MiB;
static_assert(WS_HID + (size_t)M * FF * 2 <= WS_YA + (size_t)M * D * 2 && WS_YA + (size_t)M * D * 2 == WS_END, "ws map");

constexpr int LDS_BYTES = 147456;

using pg8::Unit; using pg8::BM; using pg8::HALF;

struct EpiProj {
    static constexpr bool PERM = true; static constexpr int MID = 0;
    const float* rstd; const float* lbp; bf16_t *U, *Q, *G, *V, *SG, *RAT, *GB;
    __device__ __forceinline__ void operator()(const f32x4 (&acc)[2][2][4][2], const Unit& u, int wr, int wc, int fr, int fq) const {
        const int row0 = u.pm * BM + wr * 64 + fr, cw = wc * 32 + 8 * fq, pn = u.pn;
        float rsv[2][4];
#pragma unroll
        for (int ai = 0; ai < 2; ++ai)
#pragma unroll
            for (int m = 0; m < 4; ++m) rsv[ai][m] = rstd[row0 + ai * HALF + m * 16];
        asm volatile("" ::: "memory");
        if (pn < 4) {
#pragma unroll
            for (int ai = 0; ai < 2; ++ai)
#pragma unroll
                for (int m = 0; m < 4; ++m) { const int row = row0 + ai * HALF + m * 16; const float rs = rsv[ai][m];
                    const f32x4 a0 = acc[ai][0][m][0] * rs, g0 = acc[ai][1][m][0] * rs, a1 = acc[ai][0][m][1] * rs, g1 = acc[ai][1][m][1] * rs;
                    u32x4 w; w.x = pk_bf16(a0[0] * sigm(g0[0]), a0[1] * sigm(g0[1])); w.y = pk_bf16(a0[2] * sigm(g0[2]), a0[3] * sigm(g0[3]));
                    w.z = pk_bf16(a1[0] * sigm(g1[0]), a1[1] * sigm(g1[1])); w.w = pk_bf16(a1[2] * sigm(g1[2]), a1[3] * sigm(g1[3]));
                    *(u32x4*)(U + (size_t)row * CW + pn * 128 + cw) = w; }
        } else if (pn < 12) {
            const int mode = (pn - 4) >> 1, cb = ((pn - 4) & 1) * 256;
            bf16_t* dst = Q + (size_t)mode * ((size_t)M * HW);
            if (mode == 1) {
#pragma unroll
                for (int bj = 0; bj < 2; ++bj) { const int c = cb + bj * HALF + cw;
                    const f32x4 l0a = *(const f32x4*)(lbp + c), l0b = *(const f32x4*)(lbp + c + 4), l1a = *(const f32x4*)(lbp + HW + c), l1b = *(const f32x4*)(lbp + HW + c + 4);
                    f32x4 lba, lbb;
#pragma unroll
                    for (int j = 0; j < 4; ++j) { lba[j] = sigm(l0a[j] - l1a[j]); lbb[j] = sigm(l0b[j] - l1b[j]); }
#pragma unroll
                    for (int ai = 0; ai < 2; ++ai)
#pragma unroll
                        for (int m = 0; m < 4; ++m) { const int row = row0 + ai * HALF + m * 16; const float rs = rsv[ai][m];
                            f32x4 z0 = acc[ai][bj][m][0] * rs, z1 = acc[ai][bj][m][1] * rs;
#pragma unroll
                            for (int j = 0; j < 4; ++j) { z0[j] = __logf(lba[j] + (1.0f - lba[j]) * sigm(z0[j])); z1[j] = __logf(lbb[j] + (1.0f - lbb[j]) * sigm(z1[j])); }
                            u32x4 w; w.x = pk_bf16(z0[0], z0[1]); w.y = pk_bf16(z0[2], z0[3]); w.z = pk_bf16(z1[0], z1[1]); w.w = pk_bf16(z1[2], z1[3]);
                            *(u32x4*)(dst + (size_t)row * HW + c) = w; } }
            } else {
#pragma unroll
                for (int ai = 0; ai < 2; ++ai)
#pragma unroll
                    for (int m = 0; m < 4; ++m) { const int row = row0 + ai * HALF + m * 16; const float rs = rsv[ai][m];
#pragma unroll
                        for (int bj = 0; bj < 2; ++bj) { f32x4 z0 = acc[ai][bj][m][0] * rs, z1 = acc[ai][bj][m][1] * rs;
                            if (mode == 3) {
#pragma unroll
                                for (int j = 0; j < 4; ++j) { z0[j] = z0[j] * sigm(z0[j]); z1[j] = z1[j] * sigm(z1[j]); } }
                            u32x4 w; w.x = pk_bf16(z0[0], z0[1]); w.y = pk_bf16(z0[2], z0[3]); w.z = pk_bf16(z1[0], z1[1]); w.w = pk_bf16(z1[2], z1[3]);
                            *(u32x4*)(dst + (size_t)row * HW + cb + bj * HALF + cw) = w; } }
            }
        } else {
            const int cb = (pn - 12) * 128 + cw;
#pragma unroll
            for (int ai = 0; ai < 2; ++ai)
#pragma unroll
                for (int m = 0; m < 4; ++m) { const int row = row0 + ai * HALF + m * 16; const float rs = rsv[ai][m]; f32x4 r0, r1, b0, b1;
#pragma unroll
                    for (int j = 0; j < 4; ++j) {
                        { const float za = fminf(fmaxf(acc[ai][0][m][0][j] * rs, -30.f), 30.f), zb = fminf(fmaxf(acc[ai][1][m][0][j] * rs, -30.f), 30.f);
                          const float ea = 1.0f + __expf(-za), eb = 1.0f + __expf(-zb); b0[j] = __builtin_amdgcn_rcpf(eb); r0[j] = eb * __builtin_amdgcn_rcpf(ea); }
                        { const float za = fminf(fmaxf(acc[ai][0][m][1][j] * rs, -30.f), 30.f), zb = fminf(fmaxf(acc[ai][1][m][1][j] * rs, -30.f), 30.f);
                          const float ea = 1.0f + __expf(-za), eb = 1.0f + __expf(-zb); b1[j] = __builtin_amdgcn_rcpf(eb); r1[j] = eb * __builtin_amdgcn_rcpf(ea); } }
                    u32x4 w; w.x = pk_bf16(r0[0], r0[1]); w.y = pk_bf16(r0[2], r0[3]); w.z = pk_bf16(r1[0], r1[1]); w.w = pk_bf16(r1[2], r1[3]);
                    *(u32x4*)(RAT + (size_t)row * D + cb) = w;
                    w.x = pk_bf16(b0[0], b0[1]); w.y = pk_bf16(b0[2], b0[3]); w.z = pk_bf16(b1[0], b1[1]); w.w = pk_bf16(b1[2], b1[3]);
                    *(u32x4*)(GB + (size_t)row * D + cb) = w; }
        }
    }
};

struct EpiY {
    static constexpr bool PERM = true; static constexpr int MID = 8;
    const bf16_t* RAT; const bf16_t* GB; const float* bias; bf16_t* Y;
    __device__ __forceinline__ void mid(f32x4 (&acc)[2][2][4][2], const Unit& u, int wr, int wc, int fr, int fq) const {
        const int row0 = u.pm * BM + wr * 64 + fr, col0 = u.pn * BM + wc * 32 + 8 * fq;
        u32x4 rw[2][4][2];
#pragma unroll
        for (int ai = 0; ai < 2; ++ai)
#pragma unroll
            for (int m = 0; m < 4; ++m)
#pragma unroll
                for (int bj = 0; bj < 2; ++bj) rw[ai][m][bj] = *(const u32x4*)(RAT + (size_t)(row0 + ai * HALF + m * 16) * D + col0 + bj * HALF);
#pragma unroll
        for (int bj = 0; bj < 2; ++bj) { const f32x4 b0 = *(const f32x4*)(bias + col0 + bj * HALF), b1 = *(const f32x4*)(bias + col0 + bj * HALF + 4);
#pragma unroll
            for (int ai = 0; ai < 2; ++ai)
#pragma unroll
                for (int m = 0; m < 4; ++m) { const u32x4 w = rw[ai][m][bj];
                    acc[ai][bj][m][0] = (acc[ai][bj][m][0] + b0) * (f32x4){bf_lo(w.x), bf_hi(w.x), bf_lo(w.y), bf_hi(w.y)};
                    acc[ai][bj][m][1] = (acc[ai][bj][m][1] + b1) * (f32x4){bf_lo(w.z), bf_hi(w.z), bf_lo(w.w), bf_hi(w.w)}; } }
        asm volatile("" ::: "memory");
    }
    __device__ __forceinline__ void operator()(const f32x4 (&acc)[2][2][4][2], const Unit& u, int wr, int wc, int fr, int fq) const {
        const int row0 = u.pm * BM + wr * 64 + fr, col0 = u.pn * BM + wc * 32 + 8 * fq;
        u32x4 gw[2][4][2];
#pragma unroll
        for (int ai = 0; ai < 2; ++ai)
#pragma unroll
            for (int m = 0; m < 4; ++m)
#pragma unroll
                for (int bj = 0; bj < 2; ++bj) gw[ai][m][bj] = *(const u32x4*)(GB + (size_t)(row0 + ai * HALF + m * 16) * D + col0 + bj * HALF);
        asm volatile("" ::: "memory");
#pragma unroll
        for (int ai = 0; ai < 2; ++ai)
#pragma unroll
            for (int m = 0; m < 4; ++m) { const int row = row0 + ai * HALF + m * 16;
#pragma unroll
                for (int bj = 0; bj < 2; ++bj) { const u32x4 w = gw[ai][m][bj];
                    const f32x4 v0 = acc[ai][bj][m][0] * (f32x4){bf_lo(w.x), bf_hi(w.x), bf_lo(w.y), bf_hi(w.y)};
                    const f32x4 v1 = acc[ai][bj][m][1] * (f32x4){bf_lo(w.z), bf_hi(w.z), bf_lo(w.w), bf_hi(w.w)};
                    u32x4 o; o.x = pk_bf16(v0[0], v0[1]); o.y = pk_bf16(v0[2], v0[3]); o.z = pk_bf16(v1[0], v1[1]); o.w = pk_bf16(v1[2], v1[3]);
                    *(u32x4*)(Y + (size_t)row * D + col0 + bj * HALF) = o; } }
    }
};

template <bool WITH_BF> struct EpiRes {
    static constexpr bool PERM = false; static constexpr int MID = 0;
    const float* base; float* out; bf16_t* xb; unsigned long long* ss;
    __device__ __forceinline__ void operator()(const f32x4 (&acc)[2][2][4][2], const Unit& u, int wr, int wc, int fr, int fq) const {
        const int row0 = u.pm * BM + wr * 64 + fr, col0 = u.pn * BM + wc * 32 + 4 * fq;
#pragma unroll
        for (int ai = 0; ai < 2; ++ai) {
            f32x4 bv[4][2][2];
#pragma unroll
            for (int m = 0; m < 4; ++m)
#pragma unroll
                for (int bj = 0; bj < 2; ++bj)
#pragma unroll
                    for (int n = 0; n < 2; ++n) bv[m][bj][n] = *(const f32x4*)(base + (size_t)(row0 + ai * HALF + m * 16) * D + col0 + bj * HALF + n * 16);
            asm volatile("" ::: "memory");
#pragma unroll
            for (int m = 0; m < 4; ++m) { const int row = row0 + ai * HALF + m * 16; const size_t off = (size_t)row * D + col0; float s = 0.f;
#pragma unroll
                for (int bj = 0; bj < 2; ++bj)
#pragma unroll
                    for (int n = 0; n < 2; ++n) { const size_t o2 = off + bj * HALF + n * 16; const f32x4 o = bv[m][bj][n] + acc[ai][bj][m][n];
                        *(f32x4*)(out + o2) = o; s += (o[0] * o[0] + o[1] * o[1]) + (o[2] * o[2] + o[3] * o[3]);
                        if (WITH_BF) { u32x2 w; w.x = pk_bf16(o[0], o[1]); w.y = pk_bf16(o[2], o[3]); *(u32x2*)(xb + o2) = w; } }
                s += __shfl_xor(s, 16); s += __shfl_xor(s, 32);
                if (fq == 0) atomicAdd(ss + row, (unsigned long long)(s * SS_SCALE)); }
            asm volatile("" ::: "memory");
        }
    }
};

struct EpiUp {
    static constexpr bool PERM = true; static constexpr int MID = 0;
    const unsigned long long* ss; bf16_t* H;
    __device__ __forceinline__ void operator()(const f32x4 (&acc)[2][2][4][2], const Unit& u, int wr, int wc, int fr, int fq) const {
        const int row0 = u.pm * BM + wr * 64 + fr, col0 = u.pn * BM + wc * 32 + 8 * fq;
        unsigned long long sv[2][4];
#pragma unroll
        for (int ai = 0; ai < 2; ++ai)
#pragma unroll
            for (int m = 0; m < 4; ++m) sv[ai][m] = ss[row0 + ai * HALF + m * 16];
        asm volatile("" ::: "memory");
#pragma unroll
        for (int ai = 0; ai < 2; ++ai)
#pragma unroll
            for (int m = 0; m < 4; ++m) { const int row = row0 + ai * HALF + m * 16; const float rs = rsqrtf((float)sv[ai][m] * SS_INV + NORM_EPS);
#pragma unroll
                for (int bj = 0; bj < 2; ++bj) { f32x4 v0 = acc[ai][bj][m][0] * rs, v1 = acc[ai][bj][m][1] * rs;
#pragma unroll
                    for (int j = 0; j < 4; ++j) { v0[j] = fmaxf(v0[j], 0.f); v1[j] = fmaxf(v1[j], 0.f); }
                    v0 = v0 * v0; v1 = v1 * v1;
                    u32x4 o; o.x = pk_bf16(v0[0], v0[1]); o.y = pk_bf16(v0[2], v0[3]); o.z = pk_bf16(v1[0], v1[1]); o.w = pk_bf16(v1[2], v1[3]);
                    *(u32x4*)(H + (size_t)row * FF + col0 + bj * HALF) = o; } }
    }
};


#define XB_TMO      128
#define XB_XCNT(j)  (256  + 64 * (j))
#define XB_XSUB(j)  (1280 + 64 * (j))
#define XB_XGEN(j)  (2304 + 64 * (j))
#define XB_TOP      3328
#define XB_TOPGEN   3392
#define XCD_BAR_WORDS 3456
#define XB_SPIN_CAP (1u << 18)
__device__ __forceinline__ unsigned xb_ld(unsigned* p)              { return __hip_atomic_load(p, __ATOMIC_RELAXED, __HIP_MEMORY_SCOPE_AGENT); }
__device__ __forceinline__ unsigned xb_add(unsigned* p, unsigned v) { return __hip_atomic_fetch_add(p, v, __ATOMIC_RELAXED, __HIP_MEMORY_SCOPE_AGENT); }
__device__ __forceinline__ unsigned xb_xcc_id() { return (unsigned)__builtin_amdgcn_s_getreg((3 << 11) | 20) & 0xFu; }
#define XB_SPIN(cond, bar) do { unsigned _sp = 0; while (cond) { __builtin_amdgcn_s_sleep(1); \
    if ((++_sp & 255u) == 0u) { if (xb_ld(&(bar)[XB_TMO])) break; if (_sp > XB_SPIN_CAP) { atomicAdd(&(bar)[XB_TMO], 1u); break; } } } } while (0)
struct XcdBarrier { unsigned* bar; unsigned x; volatile LAS unsigned* st; };
__device__ __forceinline__ XcdBarrier xcd_barrier_post(unsigned* bar, volatile LAS unsigned* st) {
    XcdBarrier b; b.bar = bar; b.x = xb_xcc_id(); b.st = st;
    if (threadIdx.x == 0) (void)xb_add(&bar[XB_XCNT(b.x)], 1u);
    return b;
}
__device__ __forceinline__ void xcd_barrier_complete(unsigned* bar, unsigned x, unsigned& nloc, unsigned& nx) {
    const unsigned G = gridDim.x * gridDim.y * gridDim.z;
    unsigned sum, cnt, mine, sp = 0u;
    for (;;) {
        sum = 0u; cnt = 0u; mine = 0u;
#pragma unroll
        for (unsigned j = 0; j < 16; ++j) { const unsigned c = xb_ld(&bar[XB_XCNT(j)]); sum += c; cnt += (c > 0u) ? 1u : 0u; mine = (j == x) ? c : mine; }
        if (sum == G) break;
        __builtin_amdgcn_s_sleep(1);
        if ((++sp & 255u) == 0u) { if (xb_ld(&bar[XB_TMO])) break; if (sp > XB_SPIN_CAP) { atomicAdd(&bar[XB_TMO], 1u); break; } }
    }
    nloc = mine > 0u ? mine : 1u; nx = cnt > 0u ? cnt : 1u;
}
__device__ __forceinline__ void xcd_barrier(const XcdBarrier& b) {
    asm volatile("s_waitcnt vmcnt(0)" ::: "memory");
    __syncthreads();
    if (threadIdx.x == 0) {
        unsigned* bar = b.bar;
        __builtin_amdgcn_s_waitcnt(0);
        unsigned nloc = b.st[0], nx = b.st[1];
        if (nloc == 0u) { xcd_barrier_complete(bar, b.x, nloc, nx); b.st[0] = nloc; b.st[1] = nx; }
        const unsigned old = xb_add(&bar[XB_XSUB(b.x)], 1u);
        const unsigned gen = old / nloc;
        if (old + 1u == (gen + 1u) * nloc) {
            __builtin_amdgcn_fence(__ATOMIC_RELEASE, "agent");
            asm volatile("s_waitcnt vmcnt(0)" ::: "memory");
            const unsigned og = xb_add(&bar[XB_TOP], 1u);
            const unsigned tg = og / nx;
            if (og + 1u == (tg + 1u) * nx) xb_add(&bar[XB_TOPGEN], 1u);
            else XB_SPIN(xb_ld(&bar[XB_TOPGEN]) == tg, bar);
            __builtin_amdgcn_fence(__ATOMIC_ACQUIRE, "agent");
            xb_add(&bar[XB_XGEN(b.x)], 1u);
            asm volatile("s_waitcnt vmcnt(0)" ::: "memory");
        } else {
            XB_SPIN(xb_ld(&bar[XB_XGEN(b.x)]) == gen, bar);
            __builtin_amdgcn_fence(__ATOMIC_ACQUIRE, "agent");
            asm volatile("s_waitcnt vmcnt(0)" ::: "memory");
        }
    }
    __syncthreads();
}

struct Args { const float* in[17]; float* out; unsigned char* ws; int ph_lo, ph_hi; };

__device__ __forceinline__ void p0_transpose_item(const float* W, int N, bf16_t* WT, int ldk, int k_off, int drow0, const float* scale, LAS float* scr, int k0, int n0, int lane) {
#pragma unroll 8
    for (int i = 0; i < 32; ++i) { const int kk = 2 * i + (lane >> 5); float v = W[(size_t)(k0 + kk) * N + n0 + (lane & 31)]; if (scale) v *= scale[k0 + kk]; scr[kk * 33 + (lane & 31)] = v; }
    asm volatile("s_waitcnt lgkmcnt(0)" ::: "memory");
    const int c = lane & 7;
#pragma unroll
    for (int j = 0; j < 4; ++j) { const int n = (lane >> 3) + 8 * j; const LAS float* s = scr + (8 * c) * 33 + n;
        u32x4 o; o.x = pk_bf16(s[0 * 33], s[1 * 33]); o.y = pk_bf16(s[2 * 33], s[3 * 33]); o.z = pk_bf16(s[4 * 33], s[5 * 33]); o.w = pk_bf16(s[6 * 33], s[7 * 33]);
        *(u32x4*)(WT + (size_t)(drow0 + n) * ldk + k_off + k0 + 8 * c) = o; }
    asm volatile("s_waitcnt lgkmcnt(0)" ::: "memory");
}
__device__ __forceinline__ int win_dest_row(int n) {
    if (n < 512) return 256 * (n >> 7) + (n & 127);
    if (n < 1024) { const int q = n - 512; return 256 * (q >> 7) + 128 + (q & 127); }
    if (n < 3072) return n;
    if (n < 4096) { const int q = n - 3072; return 3072 + 256 * (q >> 7) + (q & 127); }
    const int q = n - 4096; return 3072 + 256 * (q >> 7) + 128 + (q & 127);
}

constexpr int CV_T = 32, CV_IN_ROWS = CV_T + CK - 1  , CV_OUT_OFF = CV_IN_ROWS * CW * 2  ;
__device__ __forceinline__ void conv_item(LAS unsigned char* lds, const bf16_t* U, const float* dw_w, const float* dw_b, const float* ln_w, const float* ln_b, bf16_t* YA, int item, int tid, int wave, int lane) {
    const int b = item >> 7, t0 = (item & 127) * CV_T; const size_t rowb = (size_t)b * SEQ;
    for (int i = tid; i < CV_IN_ROWS * 64; i += NTHR) { const int r = i >> 6, c = i & 63, tok = t0 - (CK - 1) + r;
        u32x4 v = (u32x4){0u, 0u, 0u, 0u}; if (tok >= 0) v = *(const u32x4*)(U + (rowb + tok) * CW + c * 8);
        *(LAS u32x4*)(lds + r * 1024 + c * 16) = v; }
    const int cp = tid & 255, th = tid >> 8, c0 = 2 * cp;
    f32x2 w[CK];
#pragma unroll
    for (int j = 0; j < CK; ++j) w[j] = *(const f32x2*)(dw_w + j * CW + c0);
    const f32x2 bias = *(const f32x2*)(dw_b + c0);
    __syncthreads();
    LAS float* OUT = (LAS float*)(lds + CV_OUT_OFF);
#pragma unroll 1
    for (int sb = 0; sb < 2; ++sb) { const int base = th * 16 + sb * 8;
        unsigned in[38];
#pragma unroll
        for (int r = 0; r < 38; ++r) in[r] = *(const LAS unsigned*)(lds + (base + r) * 1024 + cp * 4);
#pragma unroll
        for (int o = 0; o < 8; ++o) { float a0 = bias.x, a1 = bias.y;
#pragma unroll
            for (int j = 0; j < CK; ++j) { a0 += w[j].x * bf_lo(in[o + j]); a1 += w[j].y * bf_hi(in[o + j]); }
            *(LAS f32x2*)(OUT + (base + o) * CW + c0) = (f32x2){a0, a1}; } }
    __syncthreads();
    const f32x4 lw0 = *(const f32x4*)(ln_w + 4 * lane), lw1 = *(const f32x4*)(ln_w + 256 + 4 * lane), lb0 = *(const f32x4*)(ln_b + 4 * lane), lb1 = *(const f32x4*)(ln_b + 256 + 4 * lane);
#pragma unroll
    for (int tk = 0; tk < 4; ++tk) { const int tok = wave * 4 + tk;
        f32x4 v0 = *(const LAS f32x4*)(OUT + tok * CW + 4 * lane), v1 = *(const LAS f32x4*)(OUT + tok * CW + 256 + 4 * lane);
        const float mean = wave_sum((v0[0] + v0[1]) + (v0[2] + v0[3]) + (v1[0] + v1[1]) + (v1[2] + v1[3])) * (1.0f / CW);
        v0 = v0 - mean; v1 = v1 - mean;
        const float var = wave_sum((v0[0] * v0[0] + v0[1] * v0[1]) + (v0[2] * v0[2] + v0[3] * v0[3]) + (v1[0] * v1[0] + v1[1] * v1[1]) + (v1[2] * v1[2] + v1[3] * v1[3])) * (1.0f / CW);
        const float rstd = rsqrtf(var + LN_EPS);
        v0 = v0 * rstd * lw0 + lb0; v1 = v1 * rstd * lw1 + lb1;
#pragma unroll
        for (int j = 0; j < 4; ++j) { v0[j] = v0[j] * sigm(v0[j]); v1[j] = v1[j] * sigm(v1[j]); }
        bf16_t* o = YA + (rowb + t0 + tok) * D;
        u32x2 p; p.x = pk_bf16(v0[0], v0[1]); p.y = pk_bf16(v0[2], v0[3]); *(u32x2*)(o + 4 * lane) = p;
        p.x = pk_bf16(v1[0], v1[1]); p.y = pk_bf16(v1[2], v1[3]); *(u32x2*)(o + 256 + 4 * lane) = p; }
    __syncthreads();
}

constexpr int HG_PS = 0, HG_TS = 72  , HG_NS = 136  ;
constexpr int HA_KT = 4096, HA_VT = HA_KT + 128 * HG_TS * 2;
constexpr int HC_QN = 4096, HC_KN = HC_QN + 64 * HG_NS * 2, HC_VT = HC_KN + 64 * HG_NS * 2, HC_SSQ = HC_VT + 128 * HG_TS * 2;

__device__ __forceinline__ void hgrn_a_unit(LAS unsigned char* lds, const bf16_t* G, const bf16_t* V, float* ACH, float* DCH, int unit, int wave, int lane) {
    const int h = unit & 3; const size_t row0 = (size_t)(unit >> 2) * CH; const int ch = 2 * lane, tg = wave;
    LAS float* PS = (LAS float*)(lds + HG_PS);
    unsigned gw[8], vw[8];
#pragma unroll
    for (int i = 0; i < 8; ++i) { const size_t off = (row0 + tg * 8 + i) * HW + h * HD + ch; gw[i] = *(const unsigned*)(G + off); vw[i] = *(const unsigned*)(V + off); }
    float bl0[8], bl1[8]; float s0 = 0.f, s1 = 0.f;
#pragma unroll
    for (int i = 0; i < 8; ++i) { s0 += bf_lo(gw[i]); s1 += bf_hi(gw[i]); bl0[i] = s0; bl1[i] = s1; }
    *(LAS f32x2*)(PS + tg * HD + ch) = (f32x2){s0, s1};
    __syncthreads();
    float pre0 = 0.f, pre1 = 0.f, tot0 = 0.f, tot1 = 0.f;
#pragma unroll
    for (int j = 0; j < 8; ++j) { const f32x2 p = *(const LAS f32x2*)(PS + j * HD + ch); tot0 += p.x; tot1 += p.y; if (j < tg) { pre0 += p.x; pre1 += p.y; } }
    float k0[8], k1[8];
#pragma unroll
    for (int i = 0; i < 8; ++i) { k0[i] = (1.0f - __expf(bf_lo(gw[i]))) * __expf(tot0 - (pre0 + bl0[i])); k1[i] = (1.0f - __expf(bf_hi(gw[i]))) * __expf(tot1 - (pre1 + bl1[i])); }
    u32x4 w;
    w.x = pk_bf16(k0[0], k0[1]); w.y = pk_bf16(k0[2], k0[3]); w.z = pk_bf16(k0[4], k0[5]); w.w = pk_bf16(k0[6], k0[7]); *(LAS u32x4*)(lds + HA_KT + (ch * HG_TS + tg * 8) * 2) = w;
    w.x = pk_bf16(k1[0], k1[1]); w.y = pk_bf16(k1[2], k1[3]); w.z = pk_bf16(k1[4], k1[5]); w.w = pk_bf16(k1[6], k1[7]); *(LAS u32x4*)(lds + HA_KT + ((ch + 1) * HG_TS + tg * 8) * 2) = w;
    w.x = (vw[0] & 0xffffu) | (vw[1] << 16); w.y = (vw[2] & 0xffffu) | (vw[3] << 16); w.z = (vw[4] & 0xffffu) | (vw[5] << 16); w.w = (vw[6] & 0xffffu) | (vw[7] << 16); *(LAS u32x4*)(lds + HA_VT + (ch * HG_TS + tg * 8) * 2) = w;
    w.x = (vw[0] >> 16) | (vw[1] & 0xffff0000u); w.y = (vw[2] >> 16) | (vw[3] & 0xffff0000u); w.z = (vw[4] >> 16) | (vw[5] & 0xffff0000u); w.w = (vw[6] >> 16) | (vw[7] & 0xffff0000u); *(LAS u32x4*)(lds + HA_VT + ((ch + 1) * HG_TS + tg * 8) * 2) = w;
    if (tg == 0) *(f32x2*)(DCH + (size_t)unit * HD + ch) = (f32x2){__expf(tot0), __expf(tot1)};
    __syncthreads();
    const int i16 = lane & 15, kq = lane >> 4;
    bf16x8 af[2];
#pragma unroll
    for (int ks = 0; ks < 2; ++ks) af[ks] = *(const LAS bf16x8*)(lds + HA_KT + ((16 * wave + i16) * HG_TS + 32 * ks + 8 * kq) * 2);
    float* dst = ACH + (size_t)unit * (HD * HD) + 16 * wave + 4 * kq;
#pragma unroll
    for (int dvt = 0; dvt < 8; ++dvt) { f32x4 acc = (f32x4){0.f, 0.f, 0.f, 0.f};
#pragma unroll
        for (int ks = 0; ks < 2; ++ks) { const bf16x8 bfr = *(const LAS bf16x8*)(lds + HA_VT + ((16 * dvt + i16) * HG_TS + 32 * ks + 8 * kq) * 2); acc = __builtin_amdgcn_mfma_f32_16x16x32_bf16(af[ks], bfr, acc, 0, 0, 0); }
        *(f32x4*)(dst + (16 * dvt + i16) * HD) = acc; }
    __syncthreads();
}

__device__ __forceinline__ void hgrn_b_scan(const float* ACH, const float* DCH, bf16_t* SCH, int gtid, int gsz) {
    for (int item = gtid; item < BATCH * NH * (HD * HD / 4); item += gsz) {
        const int bh = item >> 12, e4 = item & 4095, b = bh >> 2, h = bh & 3, dk4 = (e4 & 31) * 4;
        f32x4 S = (f32x4){0.f, 0.f, 0.f, 0.f};
#pragma unroll 8
        for (int c = 0; c < NCH; ++c) { const size_t unit = (size_t)((b * NCH + c) * NH + h);
            u32x2 w; w.x = pk_bf16(S[0], S[1]); w.y = pk_bf16(S[2], S[3]); *(u32x2*)(SCH + unit * (HD * HD) + e4 * 4) = w;
            const f32x4 a = *(const f32x4*)(ACH + unit * (HD * HD) + e4 * 4), d = *(const f32x4*)(DCH + unit * HD + dk4);
            S = d * S + a; }
    }
}

__device__ __forceinline__ void hgrn_c_unit(LAS unsigned char* lds, const bf16_t* Q, const bf16_t* G, const bf16_t* V, const bf16_t* SG, const bf16_t* SCH, const float* norm_w, bf16_t* YA, int unit, int wave, int lane) {
    const int h = unit & 3; const size_t row0 = (size_t)(unit >> 2) * CH; const int ch = 2 * lane, tg = wave;
    LAS float* PS = (LAS float*)(lds + HG_PS);
    unsigned gw[8], qw[8], vw[8];
#pragma unroll
    for (int i = 0; i < 8; ++i) { const size_t off = (row0 + tg * 8 + i) * HW + h * HD + ch; gw[i] = *(const unsigned*)(G + off); qw[i] = *(const unsigned*)(Q + off); vw[i] = *(const unsigned*)(V + off); }
    float bl0[8], bl1[8]; float s0 = 0.f, s1 = 0.f;
#pragma unroll
    for (int i = 0; i < 8; ++i) { s0 += bf_lo(gw[i]); s1 += bf_hi(gw[i]); bl0[i] = s0; bl1[i] = s1; }
    *(LAS f32x2*)(PS + tg * HD + ch) = (f32x2){s0, s1};
    __syncthreads();
    float pre0 = 0.f, pre1 = 0.f;
#pragma unroll
    for (int j = 0; j < 7; ++j) { const f32x2 p = *(const LAS f32x2*)(PS + j * HD + ch); if (j < tg) { pre0 += p.x; pre1 += p.y; } }
#pragma unroll
    for (int i = 0; i < 8; ++i) { const float b0 = pre0 + bl0[i], b1 = pre1 + bl1[i];
        const unsigned qn = pk_bf16(bf_lo(qw[i]) * __expf(b0), bf_hi(qw[i]) * __expf(b1));
        const unsigned kn = pk_bf16((1.0f - __expf(bf_lo(gw[i]))) * __expf(-b0), (1.0f - __expf(bf_hi(gw[i]))) * __expf(-b1));
        *(LAS unsigned*)(lds + HC_QN + ((tg * 8 + i) * HG_NS + ch) * 2) = qn; *(LAS unsigned*)(lds + HC_KN + ((tg * 8 + i) * HG_NS + ch) * 2) = kn; }
    u32x4 w;
    w.x = (vw[0] & 0xffffu) | (vw[1] << 16); w.y = (vw[2] & 0xffffu) | (vw[3] << 16); w.z = (vw[4] & 0xffffu) | (vw[5] << 16); w.w = (vw[6] & 0xffffu) | (vw[7] << 16); *(LAS u32x4*)(lds + HC_VT + (ch * HG_TS + tg * 8) * 2) = w;
    w.x = (vw[0] >> 16) | (vw[1] & 0xffff0000u); w.y = (vw[2] >> 16) | (vw[3] & 0xffff0000u); w.z = (vw[4] >> 16) | (vw[5] & 0xffff0000u); w.w = (vw[6] >> 16) | (vw[7] & 0xffff0000u); *(LAS u32x4*)(lds + HC_VT + ((ch + 1) * HG_TS + tg * 8) * 2) = w;
    __syncthreads();
    const int i16 = lane & 15, kq = lane >> 4, tt = wave >> 1, dh = wave & 1;
    bf16x8 qf[4];
#pragma unroll
    for (int ks = 0; ks < 4; ++ks) qf[ks] = *(const LAS bf16x8*)(lds + HC_QN + ((16 * tt + i16) * HG_NS + 32 * ks + 8 * kq) * 2);
    f32x4 pt[4];
#pragma unroll
    for (int st = 0; st < 4; ++st) { pt[st] = (f32x4){0.f, 0.f, 0.f, 0.f};
        if (st <= tt) {
#pragma unroll
            for (int ks = 0; ks < 4; ++ks) { const bf16x8 kf = *(const LAS bf16x8*)(lds + HC_KN + ((16 * st + i16) * HG_NS + 32 * ks + 8 * kq) * 2); pt[st] = __builtin_amdgcn_mfma_f32_16x16x32_bf16(kf, qf[ks], pt[st], 0, 0, 0); }
            if (st == tt) {
#pragma unroll
                for (int r = 0; r < 4; ++r) if (4 * kq + r > i16) pt[st][r] = 0.f; } } }
    bf16x8 pf[2];
#pragma unroll
    for (int p = 0; p < 2; ++p) { u32x4 t; t.x = pk_bf16(pt[2 * p][0], pt[2 * p][1]); t.y = pk_bf16(pt[2 * p][2], pt[2 * p][3]); t.z = pk_bf16(pt[2 * p + 1][0], pt[2 * p + 1][1]); t.w = pk_bf16(pt[2 * p + 1][2], pt[2 * p + 1][3]); pf[p] = __builtin_bit_cast(bf16x8, t); }
    f32x4 o[4]; float ssq = 0.f;
    const bf16_t* Su = SCH + (size_t)unit * (HD * HD);
#pragma unroll
    for (int dvt = 0; dvt < 4; ++dvt) { const int dv0 = 16 * (4 * dh + dvt); f32x4 acc = (f32x4){0.f, 0.f, 0.f, 0.f};
#pragma unroll
        for (int ks = 0; ks < 4; ++ks) { const bf16x8 sf = *(const bf16x8*)(Su + (dv0 + i16) * HD + 32 * ks + 8 * kq); acc = __builtin_amdgcn_mfma_f32_16x16x32_bf16(sf, qf[ks], acc, 0, 0, 0); }
#pragma unroll
        for (int p = 0; p < 2; ++p) if (2 * p <= tt) { const u32x2 lo = *(const LAS u32x2*)(lds + HC_VT + ((dv0 + i16) * HG_TS + 32 * p + 4 * kq) * 2), hi = *(const LAS u32x2*)(lds + HC_VT + ((dv0 + i16) * HG_TS + 32 * p + 16 + 4 * kq) * 2);
            const u32x4 t = (u32x4){lo.x, lo.y, hi.x, hi.y}; acc = __builtin_amdgcn_mfma_f32_16x16x32_bf16(__builtin_bit_cast(bf16x8, t), pf[p], acc, 0, 0, 0); }
        o[dvt] = acc; ssq += (acc[0] * acc[0] + acc[1] * acc[1]) + (acc[2] * acc[2] + acc[3] * acc[3]); }
    ssq += __shfl_xor(ssq, 16); ssq += __shfl_xor(ssq, 32);
    LAS float* SSQ = (LAS float*)(lds + HC_SSQ);
    if (kq == 0) SSQ[dh * 64 + 16 * tt + i16] = ssq;
    __syncthreads();
    const float rstd = rsqrtf((SSQ[16 * tt + i16] + SSQ[64 + 16 * tt + i16]) * (1.0f / HD) + NORM_EPS);
    const size_t row = row0 + 16 * tt + i16;
#pragma unroll
    for (int dvt = 0; dvt < 4; ++dvt) { const int col = h * HD + 16 * (4 * dh + dvt) + 4 * kq;
        const f32x4 nw = *(const f32x4*)(norm_w + col); const u32x2 sg = *(const u32x2*)(SG + row * HW + col);
        const f32x4 v = o[dvt] * rstd * nw * (f32x4){bf_lo(sg.x), bf_hi(sg.x), bf_lo(sg.y), bf_hi(sg.y)};
        u32x2 p; p.x = pk_bf16(v[0], v[1]); p.y = pk_bf16(v[2], v[3]); *(u32x2*)(YA + row * D + CW + col) = p; }
    __syncthreads();
}

__global__ void __launch_bounds__(NTHR, 2) mk_fwd(Args args) {
    extern __shared__ __attribute__((aligned(16))) unsigned char lds_raw[];
    LAS unsigned char* lds = (LAS unsigned char*)lds_raw;
    const int tid = threadIdx.x, lane = tid & 63, wave = __builtin_amdgcn_readfirstlane(tid >> 6);
    const int G = gridDim.x, bx = blockIdx.x;
    unsigned char* ws = args.ws;
    const float* x = args.in[0];
    float* out = args.out;
    const int lo = args.ph_lo, hi = args.ph_hi;
#ifndef PH_MASK
#define PH_MASK 0x3ff
#endif
#define IN(k) (((PH_MASK >> (k)) & 1) && lo <= (k) && (k) < hi)
#define SEAM(k) do { if (IN(k) && IN((k) + 1)) { xcd_barrier(bar); } } while (0)
    volatile LAS unsigned* MISC = (volatile LAS unsigned*)(lds + 131072);
    if (tid < 4) MISC[tid] = 0u;
    __syncthreads();
    XcdBarrier bar; bar.bar = (unsigned*)ws; bar.x = 0; bar.st = nullptr;
    if (hi - lo > 1) bar = xcd_barrier_post((unsigned*)ws, MISC);
    if (lo < 0) cg::this_grid().sync();

    if (IN(0)) {
        const int gw = bx * NWAVES + wave, NGW = G * NWAVES;
        { unsigned long long* z = (unsigned long long*)(ws + WS_SS2); for (int i = bx * NTHR + tid; i < 2 * M; i += G * NTHR) z[i] = 0ull; }
        LAS float* scr = (LAS float*)(lds + wave * 16384);
        constexpr int I_IN = (D / 64) * (INC / 32), I_PW = (CW / 64) * (D / 32), I_HO = I_PW, I_O = (D / 64) * (D / 32), I_UP = (D / 64) * (FF / 32), I_DN = (FF / 64) * (D / 32);
        constexpr int NITEMS = I_IN + I_PW + I_HO + I_O + I_UP + I_DN;
        for (int it = gw; it < NITEMS; it += NGW) {
            int r = it;
            if (r < I_IN) { const int nb = INC / 32, k0 = 64 * (r / nb), n0 = 32 * (r % nb); p0_transpose_item(args.in[2], INC, (bf16_t*)(ws + WS_WIN), D, 0, win_dest_row(n0), args.in[1], scr, k0, n0, lane); continue; } r -= I_IN;
            if (r < I_PW) { const int nb = D / 32, k0 = 64 * (r / nb), n0 = 32 * (r % nb); p0_transpose_item(args.in[7], D, (bf16_t*)(ws + WS_WCAT), D, 0, n0, nullptr, scr, k0, n0, lane); continue; } r -= I_PW;
            if (r < I_HO) { const int nb = D / 32, k0 = 64 * (r / nb), n0 = 32 * (r % nb); p0_transpose_item(args.in[11], D, (bf16_t*)(ws + WS_WCAT), D, CW, n0, nullptr, scr, k0, n0, lane); continue; } r -= I_HO;
            if (r < I_O) { const int nb = D / 32, k0 = 64 * (r / nb), n0 = 32 * (r % nb); p0_transpose_item(args.in[12], D, (bf16_t*)(ws + WS_WOUT), D, 0, n0, nullptr, scr, k0, n0, lane); continue; } r -= I_O;
            if (r < I_UP) { const int nb = FF / 32, k0 = 64 * (r / nb), n0 = 32 * (r % nb); p0_transpose_item(args.in[14], FF, (bf16_t*)(ws + WS_WUP), D, 0, n0, args.in[13], scr, k0, n0, lane); continue; } r -= I_UP;
            { const int nb = D / 32, k0 = 64 * (r / nb), n0 = 32 * (r % nb); p0_transpose_item(args.in[15], D, (bf16_t*)(ws + WS_WDN), FF, 0, n0, nullptr, scr, k0, n0, lane); }
        }
        bf16_t* XB = (bf16_t*)(ws + WS_XB); float* RS = (float*)(ws + WS_RSTD1);
        for (int m = gw; m < M; m += NGW) { const f32x4* xr = (const f32x4*)(x + (size_t)m * D) + lane; f32x4 v[4]; float s = 0.f;
#pragma unroll
            for (int j = 0; j < 4; ++j) { v[j] = xr[64 * j]; s += (v[j][0] * v[j][0] + v[j][1] * v[j][1]) + (v[j][2] * v[j][2] + v[j][3] * v[j][3]); }
            s = wave_sum(s); if (lane == 0) RS[m] = rsqrtf(s * (1.0f / D) + NORM_EPS);
            u32x2* o8 = (u32x2*)(XB + (size_t)m * D) + lane;
#pragma unroll
            for (int j = 0; j < 4; ++j) { u32x2 p; p.x = pk_bf16(v[j][0], v[j][1]); p.y = pk_bf16(v[j][2], v[j][3]); o8[64 * j] = p; } }
        __syncthreads();
    }
    SEAM(0);
    if (IN(1)) {
        pg8::Gemm g{(const bf16_t*)(ws + WS_XB), (const bf16_t*)(ws + WS_WIN), M, INC, D}; pg8::StaticOrder S; S.init(M, INC, G, bx);
        EpiProj E{(const float*)(ws + WS_RSTD1), args.in[9], (bf16_t*)(ws + WS_U), (bf16_t*)(ws + WS_Q), (bf16_t*)(ws + WS_G), (bf16_t*)(ws + WS_V), (bf16_t*)(ws + WS_SG), (bf16_t*)(ws + WS_RAT), (bf16_t*)(ws + WS_GB)};
        pg8::gemm_phase<EpiProj>(lds, g, S, E);
    }
    SEAM(1);
    if (IN(2)) {
        for (int it = bx; it < M / CV_T; it += G) conv_item(lds, (const bf16_t*)(ws + WS_U), args.in[3], args.in[4], args.in[5], args.in[6], (bf16_t*)(ws + WS_YA), it, tid, wave, lane);
        for (int it = bx; it < NUNIT; it += G) hgrn_a_unit(lds, (const bf16_t*)(ws + WS_G), (const bf16_t*)(ws + WS_V), out, (float*)(ws + WS_DCH), it, wave, lane);
    }
    SEAM(2);
    if (IN(3)) hgrn_b_scan(out, (const float*)(ws + WS_DCH), (bf16_t*)(ws + WS_SCH), bx * NTHR + tid, G * NTHR);
    SEAM(3);
    if (IN(4)) {
        for (int it = bx; it < NUNIT; it += G) hgrn_c_unit(lds, (const bf16_t*)(ws + WS_Q), (const bf16_t*)(ws + WS_G), (const bf16_t*)(ws + WS_V), (const bf16_t*)(ws + WS_SG), (const bf16_t*)(ws + WS_SCH), args.in[10], (bf16_t*)(ws + WS_YA), it, wave, lane);
    }
    SEAM(4);
    if (IN(5)) {
        pg8::Gemm g{(const bf16_t*)(ws + WS_YA), (const bf16_t*)(ws + WS_WCAT), M, D, D}; pg8::StaticOrder S; S.init(M, D, G, bx);
        EpiY E{(const bf16_t*)(ws + WS_RAT), (const bf16_t*)(ws + WS_GB), args.in[8], (bf16_t*)(ws + WS_Y)};
        pg8::gemm_phase<EpiY>(lds, g, S, E);
    }
    SEAM(5);
    if (IN(6)) {
        pg8::Gemm g{(const bf16_t*)(ws + WS_Y), (const bf16_t*)(ws + WS_WOUT), M, D, D}; pg8::StaticOrder S; S.init(M, D, G, bx);
        EpiRes<true> E{x, out, (bf16_t*)(ws + WS_X1B), (unsigned long long*)(ws + WS_SS2)};
        pg8::gemm_phase<EpiRes<true>>(lds, g, S, E);
    }
    SEAM(6);
    if (IN(7)) {
        pg8::Gemm g{(const bf16_t*)(ws + WS_X1B), (const bf16_t*)(ws + WS_WUP), M, FF, D}; pg8::StaticOrder S; S.init(M, FF, G, bx);
        EpiUp E{(const unsigned long long*)(ws + WS_SS2), (bf16_t*)(ws + WS_HID)};
        pg8::gemm_phase<EpiUp>(lds, g, S, E);
    }
    SEAM(7);
    if (IN(8)) {
        pg8::Gemm g{(const bf16_t*)(ws + WS_HID), (const bf16_t*)(ws + WS_WDN), M, D, FF}; pg8::StaticOrder S; S.init(M, D, G, bx);
        EpiRes<false> E{out, out, nullptr, (unsigned long long*)(ws + WS_SS3)};
        pg8::gemm_phase<EpiRes<false>>(lds, g, S, E);
    }
    SEAM(8);
    if (IN(9)) {
        const int gw = bx * NWAVES + wave, NGW = G * NWAVES; const unsigned long long* ss = (const unsigned long long*)(ws + WS_SS3); const float* wf = args.in[16];
        f32x4 wv[4];
#pragma unroll
        for (int j = 0; j < 4; ++j) wv[j] = *((const f32x4*)wf + lane + 64 * j);
        for (int m = gw; m < M; m += NGW) { f32x4* xr = (f32x4*)(out + (size_t)m * D) + lane; const float rs = rsqrtf((float)ss[m] * SS_INV + NORM_EPS);
#pragma unroll
            for (int j = 0; j < 4; ++j) xr[64 * j] = xr[64 * j] * rs * wv[j]; }
    }
#undef IN
#undef SEAM
}

extern "C" void kernel_launch(void* const* d_in, const int* in_sizes, int n_in, void* d_out, int out_size, void* d_ws, size_t ws_size, hipStream_t stream) {
    static int grid = 0;
    if (grid == 0) {
        if (n_in != 17 || in_sizes[0] != M * D || out_size != M * D || ws_size < WS_END) { fprintf(stderr, "kernel_launch: unexpected shapes (n_in %d, in0 %d, out %d, ws %zu)\n", n_in, n_in > 0 ? in_sizes[0] : -1, out_size, ws_size); grid = -1; return; }
        int dev = 0, cus = 0, per_cu = 0;
        if (hipGetDevice(&dev) != hipSuccess || hipDeviceGetAttribute(&cus, hipDeviceAttributeMultiprocessorCount, dev) != hipSuccess) { grid = -1; return; }
        if (hipFuncSetAttribute((const void*)mk_fwd, hipFuncAttributeMaxDynamicSharedMemorySize, LDS_BYTES) != hipSuccess) { fprintf(stderr, "kernel_launch: hipFuncSetAttribute failed\n"); grid = -1; return; }
        if (hipOccupancyMaxActiveBlocksPerMultiprocessor(&per_cu, (const void*)mk_fwd, NTHR, LDS_BYTES) != hipSuccess || per_cu < 1) { fprintf(stderr, "kernel_launch: occupancy query gave %d\n", per_cu); per_cu = 1; }
        (void)hipGetLastError();
        grid = cus * per_cu;
    }
    if (grid < 0) return;
    Args a{};
    for (int i = 0; i < 17; ++i) a.in[i] = (const float*)d_in[i];
    a.out = (float*)d_out; a.ws = (unsigned char*)d_ws;
#if MK_N_LAUNCHES == 1
    a.ph_lo = 0; a.ph_hi = 10;
    if (hipMemsetAsync(d_ws, 0, 16384, stream) != hipSuccess) { fprintf(stderr, "kernel_launch: memset of barrier words failed\n"); return; }
    void* kargs[] = {&a};
    hipError_t e = hipLaunchCooperativeKernel((const void*)mk_fwd, dim3(grid), dim3(NTHR), kargs, LDS_BYTES, stream);
    if (e != hipSuccess) fprintf(stderr, "cooperative launch failed: %s (grid %d)\n", hipGetErrorString(e), grid);
#else
    for (int p = 0; p < 10; ++p) { a.ph_lo = p; a.ph_hi = p + 1; hipLaunchKernelGGL(mk_fwd, dim3(grid), dim3(NTHR), LDS_BYTES, stream, a); }
#endif
}
```
